# Optimizing an MI355X kernel written in HIP

```python
import math
import jax, jax.numpy as jnp
from jax import lax
import numpy as np

D_MODEL = 1024
BATCH = 1
SEQ = 16384
DEPTH = 4

EPS = 1e-6
BLOCK = 128

MLA_HEADS = 8
MLA_Q_LORA = 256
MLA_KV_LORA = 128
MLA_NOPE = 64
MLA_ROPE = 32
MLA_V = 64
ROPE_BASE = 10000.0

DIL_HEADS = 8
DIL_HEAD_DIM = 64
DIL_PATTERNS = ((128, 1), (512, 4), (2048, 16))

SWA_Q_HEADS = 16
SWA_KV_HEADS = 2
SWA_HEAD_DIM = 64
SWA_WINDOW = 128

D_FF = -(-8 * D_MODEL // (3 * 256)) * 256

N_EVEN = (DEPTH + 1) // 2
N_ODD = DEPTH // 2

MIX_IN_A = MLA_Q_LORA + MLA_KV_LORA + MLA_ROPE
MIX_IN_B = 3 * DIL_HEADS * DIL_HEAD_DIM
MIX_IN = MIX_IN_A + MIX_IN_B
MIX_OUT = MLA_HEADS * MLA_V + DIL_HEADS * DIL_HEAD_DIM
MLA_QK = MLA_NOPE + MLA_ROPE
SWA_QKV = (SWA_Q_HEADS + 2 * SWA_KV_HEADS) * SWA_HEAD_DIM
SWA_OUT = SWA_Q_HEADS * SWA_HEAD_DIM

kernel_name = "hybrid_mla_dilated_swa_sink_trunk"


def _rmsnorm(x, g):
    xf = x.astype(jnp.float32)
    y = xf * lax.rsqrt(jnp.mean(xf * xf, axis=-1, keepdims=True) + EPS)
    return (y * g.astype(jnp.float32)).astype(x.dtype)


def _alibi_slopes(n):
    return jnp.exp2(-8.0 * jnp.arange(1, n + 1, dtype=jnp.float32) / n)


def _rope_tables(seq, dim):
    pos = jnp.arange(seq, dtype=jnp.float32)
    inv_freq = ROPE_BASE ** (-jnp.arange(0, dim, 2, dtype=jnp.float32) / dim)
    ang = pos[:, None] * inv_freq[None, :]
    return jnp.cos(ang), jnp.sin(ang)


def _rope(x, cos, sin):
    half = x.shape[-1] // 2
    x1, x2 = x[..., :half], x[..., half:]
    c = cos.astype(x.dtype)
    s = sin.astype(x.dtype)
    return jnp.concatenate([x1 * c - x2 * s, x2 * c + x1 * s], axis=-1)


def _to_blocks(t):
    b, s, h, d = t.shape
    return t.reshape(b, s // BLOCK, BLOCK, h, d).transpose(1, 0, 2, 3, 4)


def _from_blocks(t):
    nb, b, blk, h, d = t.shape
    return t.transpose(1, 0, 2, 3, 4).reshape(b, nb * blk, h * d)


def _mla_causal_attention(q, k, v):
    S = q.shape[1]
    nb = S // BLOCK
    scale = 1.0 / math.sqrt(q.shape[-1])
    kpos = jnp.arange(S)

    def one(args):
        qi, bi = args
        s = jnp.einsum('bqhd,bshd->bhqs', qi, k).astype(jnp.float32) * scale
        qpos = bi * BLOCK + jnp.arange(BLOCK)
        s = jnp.where((kpos[None, :] <= qpos[:, None])[None, None], s, -jnp.inf)
        p = jax.nn.softmax(s, axis=-1)
        return jnp.einsum('bhqs,bshd->bqhd', p.astype(v.dtype), v)

    out = lax.map(one, (_to_blocks(q), jnp.arange(nb)))
    return _from_blocks(out)


def _dilated_attention(q, k, v, slopes):
    S = q.shape[1]
    nb = S // BLOCK
    scale = 1.0 / math.sqrt(q.shape[-1])

    def one(args):
        qi, bi = args
        qpos = bi * BLOCK + jnp.arange(BLOCK)
        outs, lses = [], []
        for window, dil in DIL_PATTERNS:
            offs = dil * jnp.arange(window // dil + 1)
            kpos = qpos[:, None] - offs[None, :]
            valid = kpos >= 0
            idx = jnp.maximum(kpos, 0)
            kg = jnp.take(k, idx, axis=1)
            vg = jnp.take(v, idx, axis=1)
            s = jnp.einsum('bqhd,bqjhd->bhqj', qi, kg).astype(jnp.float32) * scale
            s = s - slopes[:, None, None] * offs.astype(jnp.float32)[None, None, :]
            s = jnp.where(valid[None, None], s, -jnp.inf)
            lse = jax.nn.logsumexp(s, axis=-1)
            p = jnp.exp(s - lse[..., None])
            outs.append(jnp.einsum('bhqj,bqjhd->bqhd', p.astype(v.dtype), vg))
            lses.append(lse)
        w = jax.nn.softmax(jnp.stack(lses, axis=0), axis=0)
        w = w.transpose(0, 1, 3, 2)[..., None].astype(v.dtype)
        return jnp.sum(w * jnp.stack(outs, axis=0), axis=0)

    out = lax.map(one, (_to_blocks(q), jnp.arange(nb)))
    return _from_blocks(out)


def _swa_sink_attention(q, k, v, sinks, slopes):
    B_, S, Hq, dh = q.shape
    Hkv = k.shape[2]
    G = Hq // Hkv
    nb = S // BLOCK
    scale = 1.0 / math.sqrt(dh)
    qb = q.reshape(B_, nb, BLOCK, Hkv, G, dh)

    def band(t):
        cur = t.reshape(B_, nb, BLOCK, Hkv, dh)
        prev = jnp.pad(t, ((0, 0), (BLOCK, 0), (0, 0), (0, 0)))[:, :S].reshape(B_, nb, BLOCK, Hkv, dh)
        return jnp.concatenate([prev, cur], axis=2)

    kb, vb = band(k), band(v)
    qi = jnp.arange(BLOCK)
    kj = jnp.arange(2 * BLOCK)
    dist = qi[:, None] + BLOCK - kj[None, :]
    kpos = jnp.arange(nb)[:, None] * BLOCK - BLOCK + kj[None, :]
    valid = ((dist >= 0) & (dist < SWA_WINDOW))[None] & (kpos >= 0)[:, None, :]
    s = jnp.einsum('bnqkgd,bnjkd->bnkgqj', qb, kb).astype(jnp.float32) * scale
    s = s - slopes.reshape(Hkv, G)[:, :, None, None] * dist.astype(jnp.float32)
    s = jnp.where(valid[None, :, None, None], s, -jnp.inf)
    sink = jnp.broadcast_to(sinks.astype(jnp.float32).reshape(1, 1, Hkv, G, 1, 1), s.shape[:-1] + (1,))
    p = jax.nn.softmax(jnp.concatenate([s, sink], axis=-1), axis=-1)[..., :-1]
    o = jnp.einsum('bnkgqj,bnjkd->bnqkgd', p.astype(v.dtype), vb)
    return o.reshape(B_, S, Hq * dh)


def _even_mixer(h, w_in, g_q, g_kv, w_uq, w_ukv, w_out, cos, sin, dil_slopes):
    B_, S, _ = h.shape
    proj = h @ w_in
    o1 = MLA_Q_LORA
    o2 = o1 + MLA_KV_LORA
    o3 = o2 + MLA_ROPE
    nd = DIL_HEADS * DIL_HEAD_DIM
    c_q, c_kv, k_r = proj[..., :o1], proj[..., o1:o2], proj[..., o2:o3]
    qB = proj[..., o3:o3 + nd].reshape(B_, S, DIL_HEADS, DIL_HEAD_DIM)
    kB = proj[..., o3 + nd:o3 + 2 * nd].reshape(B_, S, DIL_HEADS, DIL_HEAD_DIM)
    vB = proj[..., o3 + 2 * nd:o3 + 3 * nd].reshape(B_, S, DIL_HEADS, DIL_HEAD_DIM)
    qA = (_rmsnorm(c_q, g_q) @ w_uq).reshape(B_, S, MLA_HEADS, MLA_QK)
    q_nope, q_rope = qA[..., :MLA_NOPE], qA[..., MLA_NOPE:]
    q_rope = _rope(q_rope, cos[None, :, None, :], sin[None, :, None, :])
    kv = (_rmsnorm(c_kv, g_kv) @ w_ukv).reshape(B_, S, MLA_HEADS, MLA_NOPE + MLA_V)
    k_nope, vA = kv[..., :MLA_NOPE], kv[..., MLA_NOPE:]
    k_rope = _rope(k_r, cos[None], sin[None])
    k_rope = jnp.broadcast_to(k_rope[:, :, None, :], (B_, S, MLA_HEADS, MLA_ROPE))
    oA = _mla_causal_attention(jnp.concatenate([q_nope, q_rope], axis=-1),
                               jnp.concatenate([k_nope, k_rope], axis=-1), vA)
    oB = _dilated_attention(qB, kB, vB, dil_slopes)
    return jnp.concatenate([oA, oB], axis=-1) @ w_out


def _odd_mixer(h, w_qkv, sinks, w_out, swa_slopes):
    B_, S, _ = h.shape
    qkv = h @ w_qkv
    nq = SWA_Q_HEADS * SWA_HEAD_DIM
    nk = SWA_KV_HEADS * SWA_HEAD_DIM
    q = qkv[..., :nq].reshape(B_, S, SWA_Q_HEADS, SWA_HEAD_DIM)
    k = qkv[..., nq:nq + nk].reshape(B_, S, SWA_KV_HEADS, SWA_HEAD_DIM)
    v = qkv[..., nq + nk:].reshape(B_, S, SWA_KV_HEADS, SWA_HEAD_DIM)
    return _swa_sink_attention(q, k, v, sinks, swa_slopes) @ w_out


def _swiglu(h, w_gate_up, w_down):
    gu = h @ w_gate_up
    gate, up = gu[..., :D_FF], gu[..., D_FF:]
    return (jax.nn.silu(gate) * up) @ w_down


def setup_inputs(seed: int = 0) -> dict:
    key = jax.random.key(seed)
    ks = jax.random.split(key, 16)
    f32 = jnp.float32

    def w(k, shape, fan_in):
        return jax.random.normal(k, shape, f32) * (fan_in ** -0.5)

    def gain(k, shape):
        return 1.0 + 0.05 * jax.random.normal(k, shape, f32)

    return {
        "x": jax.random.normal(ks[0], (BATCH, SEQ, D_MODEL), f32),
        "attn_norm": gain(ks[1], (DEPTH, D_MODEL)),
        "ffn_norm": gain(ks[2], (DEPTH, D_MODEL)),
        "final_norm": gain(ks[3], (D_MODEL,)),
        "e_w_in": w(ks[4], (N_EVEN, D_MODEL, MIX_IN), D_MODEL),
        "e_q_norm": gain(ks[5], (N_EVEN, MLA_Q_LORA)),
        "e_kv_norm": gain(ks[6], (N_EVEN, MLA_KV_LORA)),
        "e_w_uq": w(ks[7], (N_EVEN, MLA_Q_LORA, MLA_HEADS * MLA_QK), MLA_Q_LORA),
        "e_w_ukv": w(ks[8], (N_EVEN, MLA_KV_LORA, MLA_HEADS * (MLA_NOPE + MLA_V)), MLA_KV_LORA),
        "e_w_out": w(ks[9], (N_EVEN, MIX_OUT, D_MODEL), MIX_OUT),
        "o_w_qkv": w(ks[10], (N_ODD, D_MODEL, SWA_QKV), D_MODEL),
        "o_sinks": jax.random.normal(ks[11], (N_ODD, SWA_Q_HEADS), f32),
        "o_w_out": w(ks[12], (N_ODD, SWA_OUT, D_MODEL), SWA_OUT),
        "f_w_gate_up": w(ks[13], (DEPTH, D_MODEL, 2 * D_FF), D_MODEL),
        "f_w_down": w(ks[14], (DEPTH, D_FF, D_MODEL), D_FF),
    }


def reference(x, attn_norm, ffn_norm, final_norm, e_w_in, e_q_norm, e_kv_norm, e_w_uq,
              e_w_ukv, e_w_out, o_w_qkv, o_sinks, o_w_out, f_w_gate_up, f_w_down):
    S = x.shape[1]
    cos, sin = _rope_tables(S, MLA_ROPE)
    dil_slopes = _alibi_slopes(DIL_HEADS)
    swa_slopes = _alibi_slopes(SWA_Q_HEADS)
    h = x
    for layer in range(DEPTH):
        i = layer // 2
        hn = _rmsnorm(h, attn_norm[layer])
        if layer % 2 == 0:
            mix = _even_mixer(hn, e_w_in[i], e_q_norm[i], e_kv_norm[i], e_w_uq[i],
                              e_w_ukv[i], e_w_out[i], cos, sin, dil_slopes)
        else:
            mix = _odd_mixer(hn, o_w_qkv[i], o_sinks[i], o_w_out[i], swa_slopes)
        h = h + mix
        h = h + _swiglu(_rmsnorm(h, ffn_norm[layer]), f_w_gate_up[layer], f_w_down[layer])
    return _rmsnorm(h, final_norm)
```

```cpp
#include <hip/hip_runtime.h>
#include <hip/hip_cooperative_groups.h>
#include <cstdio>
#include <cstdint>
namespace cg = cooperative_groups;
namespace pg8 {
#define PG8_LAS __attribute__((address_space(3)))
typedef unsigned short bf16_t;
typedef short bf16x8 __attribute__((ext_vector_type(8)));
typedef float f32x4 __attribute__((ext_vector_type(4)));
typedef unsigned u32x4 __attribute__((ext_vector_type(4)));
constexpr int BM = 256, BK = 64, HALF = 128, HTB = HALF * BK * 2  , STAGE_BYTES = 8 * HTB, NXCD = 8, WGM = 8;

__host__ __device__ __forceinline__ int lds_byte(int r, int c) { const int st = (r >> 4) * 2 + (c >> 5), rr = r & 15, cc = c & 31, ob = rr * 64 + cc * 2; return st * 1024 + (ob ^ (((ob >> 9) & 1) << 5)); }
__host__ __device__ __forceinline__ void stage_rc(int b, int& R, int& C) { const int st = b / 1024, sb = b % 1024, swz = sb ^ (((sb >> 9) & 1) << 5); R = (st >> 1) * 16 + swz / 64; C = (st & 1) * 32 + (swz % 64) / 2; }
__host__ __device__ __forceinline__ int perm32(int rho) { const int n = rho >> 4, i = rho & 15; return 8 * (i >> 2) + 4 * n + (i & 3); }

struct Unit { int pm, pn; };
struct Gemm { const bf16_t* A; const bf16_t* Bt; int M, N, K; };

struct StaticOrder {
    int nM, nN, nwg, G, c;
    __host__ __device__ void init(int M, int N, int G_, int c_) { nM = M / BM; nN = N / BM; nwg = nM * nN; G = G_; c = c_; }
    __host__ __device__ bool next(int i, Unit& u) const {
        const long L = (long)i * G + c; if (L >= nwg) return false;
        int wgid = (int)L; { const int q = nwg / NXCD, r = nwg % NXCD, xcd = wgid % NXCD, off = wgid / NXCD; wgid = (xcd < r ? xcd * (q + 1) : r * (q + 1) + (xcd - r) * q) + off; }
        const int nig = WGM * nN, gid = wgid / nig, fm = gid * WGM, gsz = (nM - fm) < WGM ? (nM - fm) : WGM;
        u.pm = fm + ((wgid % nig) % gsz); u.pn = (wgid % nig) / gsz; return true;
    }
    __device__ __forceinline__ void a_ready(const Unit&) const {}
    __device__ __forceinline__ void done(const Unit&) const {}
};

__device__ __forceinline__ unsigned cvt_pk_bf16(float lo, float hi) { unsigned r; asm volatile("v_cvt_pk_bf16_f32 %0, %1, %2" : "=v"(r) : "v"(lo), "v"(hi)); return r; }
template <class Epi, class Sched, bool ALIGN_EPI = false, bool SP2 = false>
__device__ __forceinline__ void gemm_phase(PG8_LAS unsigned char* lds, const Gemm g, const Sched& S, const Epi& E, int tid_in) {
    int tid_l = tid_in; asm volatile("" : "+v"(tid_l)); const int tid = tid_l, wid = __builtin_amdgcn_readfirstlane(tid >> 6), lane = tid & 63, wr = wid >> 2, wc = wid & 3, fr = lane & 15, fq = lane >> 4;
    const int K = g.K, nt = K / BK;
    unsigned voffA[2], voffB[2];
#pragma unroll
    for (int i = 0; i < 2; ++i) { int R, C; stage_rc(tid * 16 + i * 8192, R, C); const int Rb = Epi::PERM ? ((R & ~31) + perm32(R & 31)) : R;
        voffA[i] = (unsigned)(R * K + C) * 2u; voffB[i] = (unsigned)(Rb * K + C) * 2u; }
    const size_t kstep = (size_t)(BK * 2);
    const size_t hstep = (size_t)HALF * K * 2;
    const size_t tstep = 2 * hstep;
    const unsigned ldsw = (unsigned)wid * 1024u;
    const int aoff = lds_byte(wr * 64 + fr, fq * 8), boff = lds_byte(wc * 32 + fr, fq * 8);
#define PG8_SA(b, h) (((b) * 2 + (h)) * HTB)
#define PG8_SB(b, h) ((4 + (b) * 2 + (h)) * HTB)
#define PG8_STAGE(bufoff, gbase, voff) do { _Pragma("unroll") for (int _i = 0; _i < 2; ++_i) \
        __builtin_amdgcn_global_load_lds((const unsigned*)((const char*)(gbase) + (voff)[_i]), (PG8_LAS unsigned*)(lds + (bufoff) + ldsw + _i * 8192), 16, 0, 0); } while (0)
#define PG8_LDA(dst, b, h) do { _Pragma("unroll") for (int m = 0; m < 4; ++m) _Pragma("unroll") for (int k = 0; k < 2; ++k) dst[m][k] = *(const PG8_LAS bf16x8*)(lds + PG8_SA(b, h) + aoff + m * 2048 + k * 1024); } while (0)
#define PG8_LDB(dst, b, h) do { _Pragma("unroll") for (int n = 0; n < 2; ++n) _Pragma("unroll") for (int k = 0; k < 2; ++k) dst[n][k] = *(const PG8_LAS bf16x8*)(lds + PG8_SB(b, h) + boff + n * 2048 + k * 1024); } while (0)
#define PG8_MMA(ai, bj, At, Bt) do { __builtin_amdgcn_s_setprio(1); _Pragma("unroll") for (int m = 0; m < 4; ++m) _Pragma("unroll") for (int n = 0; n < 2; ++n) _Pragma("unroll") for (int k = 0; k < 2; ++k) \
        acc[ai][bj][m][n] = __builtin_amdgcn_mfma_f32_16x16x32_bf16(Bt[n][k], At[m][k], acc[ai][bj][m][n], 0, 0, 0); __builtin_amdgcn_s_setprio(0); } while (0)
#define PG8_WAIT_V(n) asm volatile("s_waitcnt vmcnt(" #n ")" ::: "memory")
#define PG8_WAIT_L(n) asm volatile("s_waitcnt lgkmcnt(" #n ")" ::: "memory")
#define PG8_BAR __builtin_amdgcn_s_barrier()
#define PG8_SCHED __builtin_amdgcn_sched_barrier(0)
    Unit cur, nxt; int ui = 0;
    if (!S.next(0, cur)) return;
    f32x4 acc[2][2][4][2];
#pragma unroll
    for (int a = 0; a < 2; ++a)
#pragma unroll
        for (int b = 0; b < 2; ++b)
#pragma unroll
            for (int m = 0; m < 4; ++m)
#pragma unroll
                for (int n = 0; n < 2; ++n) acc[a][b][m][n] = (f32x4){0.f, 0.f, 0.f, 0.f};
    bf16x8 At[4][2], B0[2][2], B1[2][2];
    const char* cA = (const char*)g.A + (size_t)cur.pm * tstep; const char* cB = (const char*)g.Bt + (size_t)cur.pn * tstep;
    S.a_ready(cur);
    if constexpr (SP2) {
        PG8_STAGE(PG8_SB(0, 0), cB, voffB); PG8_STAGE(PG8_SB(0, 1), cB + hstep, voffB); PG8_STAGE(PG8_SA(0, 0), cA, voffA); PG8_STAGE(PG8_SA(0, 1), cA + hstep, voffA);
        if (wr == 1) PG8_BAR;
        PG8_WAIT_V(2); PG8_BAR;
        PG8_STAGE(PG8_SB(1, 0), cB + kstep, voffB); PG8_STAGE(PG8_SA(1, 0), cA + kstep, voffA); PG8_STAGE(PG8_SB(1, 1), cB + hstep + kstep, voffB);
        PG8_WAIT_V(6); PG8_BAR;
    } else {
        PG8_STAGE(PG8_SB(0, 0), cB, voffB); PG8_STAGE(PG8_SA(0, 0), cA, voffA); PG8_STAGE(PG8_SB(0, 1), cB + hstep, voffB); PG8_STAGE(PG8_SA(0, 1), cA + hstep, voffA);
        if (wr == 1) PG8_BAR;
        PG8_WAIT_V(4); PG8_BAR;
        PG8_STAGE(PG8_SB(1, 0), cB + kstep, voffB); PG8_STAGE(PG8_SA(1, 0), cA + kstep, voffA); PG8_STAGE(PG8_SB(1, 1), cB + hstep + kstep, voffB);
        PG8_WAIT_V(6); PG8_BAR;
    }
    for (;;) {
        const bool has_next = S.next(ui + 1, nxt);
        const char* nA = has_next ? (const char*)g.A + (size_t)nxt.pm * tstep : cA; const char* nB = has_next ? (const char*)g.Bt + (size_t)nxt.pn * tstep : cB;
        for (int t = 0; t < nt; t += 2) {
            const bool last = (t == nt - 2);
            const char* a1 = cA + (size_t)(t + 1) * kstep;
            const char* a2 = last ? nA : cA + (size_t)(t + 2) * kstep; const char* b2 = last ? nB : cB + (size_t)(t + 2) * kstep;
            const char* a3 = a2 + kstep; const char* b3 = b2 + kstep;
            if (last && has_next) S.a_ready(nxt);
            if constexpr (SP2) {
            PG8_LDB(B0, 0, 0); PG8_LDB(B1, 0, 1); PG8_SCHED; PG8_LDA(At, 0, 0); PG8_STAGE(PG8_SA(1, 1), a1 + hstep, voffA);
            PG8_WAIT_V(8); PG8_WAIT_L(0); PG8_BAR; PG8_MMA(0, 0, At, B0); PG8_MMA(0, 1, At, B1); PG8_BAR; PG8_SCHED;
            PG8_LDA(At, 0, 1); PG8_STAGE(PG8_SB(0, 0), b2, voffB); PG8_STAGE(PG8_SB(0, 1), b2 + hstep, voffB); PG8_STAGE(PG8_SA(0, 0), a2, voffA);
            PG8_WAIT_V(8); PG8_WAIT_L(0); PG8_BAR; PG8_MMA(1, 0, At, B0); PG8_MMA(1, 1, At, B1); PG8_BAR; PG8_SCHED;
            PG8_LDB(B0, 1, 0); PG8_LDB(B1, 1, 1); PG8_SCHED; PG8_LDA(At, 1, 0); PG8_STAGE(PG8_SA(0, 1), a2 + hstep, voffA);
            PG8_WAIT_V(8); PG8_WAIT_L(0); PG8_BAR; PG8_MMA(0, 0, At, B0); PG8_MMA(0, 1, At, B1); PG8_BAR; PG8_SCHED;
            PG8_LDA(At, 1, 1); PG8_STAGE(PG8_SB(1, 0), b3, voffB); PG8_STAGE(PG8_SB(1, 1), b3 + hstep, voffB); PG8_STAGE(PG8_SA(1, 0), a3, voffA);
            PG8_WAIT_V(8); PG8_WAIT_L(0); PG8_BAR; PG8_MMA(1, 0, At, B0); PG8_MMA(1, 1, At, B1); PG8_BAR; PG8_SCHED;
            } else {
            PG8_LDB(B0, 0, 0); PG8_SCHED; PG8_LDA(At, 0, 0); PG8_STAGE(PG8_SA(1, 1), a1 + hstep, voffA);
            PG8_WAIT_L(8); PG8_BAR; PG8_WAIT_L(0); PG8_MMA(0, 0, At, B0); PG8_BAR; PG8_SCHED;
            PG8_LDB(B1, 0, 1); PG8_STAGE(PG8_SB(0, 0), b2, voffB);
            PG8_BAR; PG8_WAIT_L(0); PG8_MMA(0, 1, At, B1); PG8_BAR;
            PG8_LDA(At, 0, 1); PG8_STAGE(PG8_SA(0, 0), a2, voffA);
            PG8_BAR; PG8_WAIT_L(0); PG8_MMA(1, 0, At, B0); PG8_BAR; PG8_SCHED;
            PG8_STAGE(PG8_SB(0, 1), b2 + hstep, voffB);
            PG8_WAIT_V(6); PG8_BAR; PG8_MMA(1, 1, At, B1); PG8_BAR;
            PG8_LDB(B0, 1, 0); PG8_SCHED; PG8_LDA(At, 1, 0); PG8_STAGE(PG8_SA(0, 1), a2 + hstep, voffA);
            PG8_WAIT_L(8); PG8_BAR; PG8_WAIT_L(0); PG8_MMA(0, 0, At, B0); PG8_BAR; PG8_SCHED;
            PG8_LDB(B1, 1, 1); PG8_STAGE(PG8_SB(1, 0), b3, voffB);
            PG8_BAR; PG8_WAIT_L(0); PG8_MMA(0, 1, At, B1); PG8_BAR;
            PG8_LDA(At, 1, 1); PG8_STAGE(PG8_SA(1, 0), a3, voffA);
            PG8_BAR; PG8_WAIT_L(0); PG8_MMA(1, 0, At, B0); PG8_BAR; PG8_SCHED;
            PG8_STAGE(PG8_SB(1, 1), b3 + hstep, voffB);
            PG8_WAIT_V(6); PG8_BAR; PG8_MMA(1, 1, At, B1); PG8_BAR;
            }
        }
        if constexpr (ALIGN_EPI) { if (wr == 0) PG8_BAR; }
        if constexpr (!Epi::AFTER_DRAIN) { E(acc, cur, wr, wc, fr, fq); S.done(cur); }
        if (!has_next) break;
#pragma unroll
        for (int a = 0; a < 2; ++a)
#pragma unroll
            for (int b = 0; b < 2; ++b)
#pragma unroll
                for (int m = 0; m < 4; ++m)
#pragma unroll
                    for (int n = 0; n < 2; ++n) acc[a][b][m][n] = (f32x4){0.f, 0.f, 0.f, 0.f};
        cur = nxt; cA = nA; cB = nB; ++ui;
        if constexpr (ALIGN_EPI) { if (wr == 1) PG8_BAR; }
    }
    PG8_WAIT_V(0);
    if constexpr (!ALIGN_EPI) { if (wr == 0) PG8_BAR; }
    PG8_BAR;
    if constexpr (Epi::AFTER_DRAIN) { E.fused(acc, cur, wr, wc, fr, fq, lds, wid, lane); S.done(cur); }
#undef PG8_SA
#undef PG8_SB
#undef PG8_STAGE
#undef PG8_LDA
#undef PG8_LDB
#undef PG8_MMA
#undef PG8_WAIT_V
#undef PG8_WAIT_L
#undef PG8_BAR
#undef PG8_SCHED
}
}
using pg8::bf16_t; using pg8::bf16x8; using pg8::f32x4; using pg8::u32x4; using pg8::Unit; using pg8::cvt_pk_bf16;
#define LAS __attribute__((address_space(3)))
typedef float f32x16 __attribute__((ext_vector_type(16)));
typedef short s16x4 __attribute__((ext_vector_type(4)));
typedef short v4i16_t __attribute__((ext_vector_type(4)));
typedef float f32x2_t __attribute__((ext_vector_type(2)));
typedef __bf16 bf16x2_t __attribute__((ext_vector_type(2)));
typedef unsigned u32x2 __attribute__((ext_vector_type(2)));

constexpr int S_ = 16384, DM = 1024, DFF = 2816;
constexpr float EPS = 1e-6f, LOG2E = 1.4426950408889634f;
constexpr float C2_64 = 0.125f * LOG2E;
constexpr float C2_96 = 0.10206207261596575f * LOG2E;
constexpr int LDS_BYTES = 131072 + 64, XB_LDS_OFF = 131072;

constexpr size_t MiB = 1u << 20;
constexpr size_t WS_BAR = 0;
constexpr size_t WS_CS = 1 * MiB;
constexpr size_t WS_LSE = 3 * MiB;
constexpr size_t WS_WIN = 8 * MiB;
constexpr size_t WS_WUQ = 16 * MiB;
constexpr size_t WS_WUKV = 17 * MiB;
constexpr size_t WS_EWOUT = 18 * MiB;
constexpr size_t WS_OQKV = 22 * MiB;
constexpr size_t WS_OWOUT = 27 * MiB;
constexpr size_t WS_WGU = 31 * MiB;
constexpr size_t WS_WD = 75 * MiB;
constexpr size_t WS_HB = 98 * MiB;
constexpr size_t WS_ACT = 130 * MiB;
constexpr size_t WS_CQ = WS_ACT;
constexpr size_t WS_CKV = WS_ACT + 8 * MiB;
constexpr size_t WS_QB = WS_ACT + 12 * MiB;
constexpr size_t WS_KB = WS_ACT + 28 * MiB;
constexpr size_t WS_VB = WS_ACT + 44 * MiB;
constexpr size_t WS_QA = WS_ACT + 60 * MiB;
constexpr size_t WS_KA = WS_ACT + 84 * MiB;
constexpr size_t WS_VA = WS_ACT + 108 * MiB;
constexpr size_t WS_OCAT = WS_ACT + 124 * MiB;
constexpr size_t WS_DPART = WS_ACT + 156 * MiB;
constexpr size_t WS_SSP = WS_ACT + 204 * MiB;
constexpr size_t WS_END = WS_ACT + 214 * MiB;
constexpr size_t WS_OQ = WS_ACT;
constexpr size_t WS_OK = WS_ACT + 32 * MiB;
constexpr size_t WS_OV = WS_ACT + 36 * MiB;
constexpr size_t WS_MID = WS_ACT;

struct Params {
  const float *x, *attn_norm, *ffn_norm, *final_norm, *e_w_in, *e_q_norm, *e_kv_norm, *e_w_uq, *e_w_ukv, *e_w_out, *o_w_qkv, *o_sinks, *o_w_out, *f_w_gate_up, *f_w_down;
  float* out; unsigned char* ws;
};

typedef const __attribute__((address_space(4))) Params* KPtr;
__device__ __forceinline__ u32x4 pack8(f32x4 a, f32x4 b) { u32x4 w; w.x = cvt_pk_bf16(a[0], a[1]); w.y = cvt_pk_bf16(a[2], a[3]); w.z = cvt_pk_bf16(b[0], b[1]); w.w = cvt_pk_bf16(b[2], b[3]); return w; }
__device__ __forceinline__ float sq4(f32x4 a) { return (a[0] * a[0] + a[1] * a[1]) + (a[2] * a[2] + a[3] * a[3]); }
__device__ __forceinline__ float ex2(float x) { return __builtin_amdgcn_exp2f(x); }
__device__ __forceinline__ float sum4v(f32x4 a) { return (a[0] + a[1]) + (a[2] + a[3]); }
__device__ __forceinline__ float sum16(const float* p) { const f32x4* q = (const f32x4*)p; return (sum4v(q[0]) + sum4v(q[1])) + (sum4v(q[2]) + sum4v(q[3])); }
__device__ __forceinline__ float* ssp_k(unsigned char* ws, int k) { return (float*)(ws + WS_SSP) + (size_t)k * S_ * 16; }
__device__ __forceinline__ float* ssq_i(unsigned char* ws, int i) { return (float*)(ws + WS_SSP) + (size_t)9 * S_ * 16 + (size_t)i * S_ * 4; }
__device__ __forceinline__ float* sskv_i(unsigned char* ws, int i) { return (float*)(ws + WS_SSP) + (size_t)9 * S_ * 16 + (size_t)(2 + i) * S_ * 4; }

#define EPI_HEAD static constexpr bool PERM = true, AFTER_DRAIN = false;
#define EPI_SIG __device__ __forceinline__ void operator()(const f32x4 (&acc)[2][2][4][2], const Unit& u, int wr, int wc, int fr_in, int fq_in) const
#define EPI_BEGIN int ln_e; asm volatile("v_mbcnt_lo_u32_b32 %0, -1, 0\n\tv_mbcnt_hi_u32_b32 %0, -1, %0" : "=v"(ln_e)); const int fr = ln_e & 15, fq = ln_e >> 4; (void)fr_in; (void)fq_in;
#define EPI_ROWLOOP _Pragma("unroll") for (int ai = 0; ai < 2; ++ai) _Pragma("unroll") for (int m = 0; m < 4; ++m)

struct EpiEvenIn { EPI_HEAD
  unsigned char* ws; int layer;
  EPI_SIG { EPI_BEGIN
    const int pn = u.pn; const int li = layer >> 1;
    const float* ss = ssp_k(ws, 2 * layer); const f32x2_t* cs = (const f32x2_t*)(ws + WS_CS);
    bf16_t *cq = (bf16_t*)(ws + WS_CQ), *ckv = (bf16_t*)(ws + WS_CKV), *kA = (bf16_t*)(ws + WS_KA), *qB = (bf16_t*)(ws + WS_QB), *kB = (bf16_t*)(ws + WS_KB), *vB = (bf16_t*)(ws + WS_VB);
    float *ssq = ssq_i(ws, li), *sskv = sskv_i(ws, li);
    EPI_ROWLOOP {
      asm volatile("" ::: "memory"); const int row = u.pm * 256 + ai * 128 + wr * 64 + m * 16 + fr;
      const float rstd = rsqrtf(sum16(ss + (size_t)row * 16) * (1.f / 1024.f) + EPS);
      if (pn == 0) {
        float sq = 0.f;
#pragma unroll
        for (int bj = 0; bj < 2; ++bj) { const f32x4 v0 = acc[ai][bj][m][0] * rstd, v1 = acc[ai][bj][m][1] * rstd; sq += sq4(v0) + sq4(v1);
          *(u32x4*)(cq + (size_t)row * 256 + bj * 128 + wc * 32 + 8 * fq) = pack8(v0, v1); }
        sq += __shfl_xor(sq, 16); sq += __shfl_xor(sq, 32);
        if (fq == 0) ssq[row * 4 + wc] = sq;
      } else if (pn == 1) {
        { const f32x4 v0 = acc[ai][0][m][0] * rstd, v1 = acc[ai][0][m][1] * rstd; float sq = sq4(v0) + sq4(v1);
          *(u32x4*)(ckv + (size_t)row * 128 + wc * 32 + 8 * fq) = pack8(v0, v1);
          sq += __shfl_xor(sq, 16); sq += __shfl_xor(sq, 32);
          if (fq == 0) sskv[row * 4 + wc] = sq; }
        if (wc == 0) {
          const f32x4 v0 = acc[ai][1][m][0] * rstd, v1 = acc[ai][1][m][1] * rstd;
          const f32x2_t c0 = cs[row * 16 + 4 * fq], c1 = cs[row * 16 + 4 * fq + 1], c2 = cs[row * 16 + 4 * fq + 2], c3 = cs[row * 16 + 4 * fq + 3];
          f32x4 y0, y1;
          y0[0] = v0[0] * c0.x - v0[1] * c0.y; y0[1] = v0[1] * c0.x + v0[0] * c0.y;
          y0[2] = v0[2] * c1.x - v0[3] * c1.y; y0[3] = v0[3] * c1.x + v0[2] * c1.y;
          y1[0] = v1[0] * c2.x - v1[1] * c2.y; y1[1] = v1[1] * c2.x + v1[0] * c2.y;
          y1[2] = v1[2] * c3.x - v1[3] * c3.y; y1[3] = v1[3] * c3.x + v1[2] * c3.y;
          const u32x4 w = pack8(y0, y1);
#pragma unroll
          for (int h = 0; h < 8; ++h) *(u32x4*)(kA + (size_t)row * 768 + h * 96 + 64 + 8 * fq) = w;
        }
      } else {
        bf16_t* dst = pn < 4 ? qB : (pn < 6 ? kB : vB); const float sc = pn < 4 ? rstd * C2_64 : rstd; const int cb = (pn & 1) * 256;
#pragma unroll
        for (int bj = 0; bj < 2; ++bj) *(u32x4*)(dst + (size_t)row * 512 + cb + bj * 128 + wc * 32 + 8 * fq) = pack8(acc[ai][bj][m][0] * sc, acc[ai][bj][m][1] * sc);
      }
    }
  }
};

struct EpiUq { EPI_HEAD
  unsigned char* ws; int li;
  EPI_SIG { EPI_BEGIN
    const float* ssq = ssq_i(ws, li); const f32x2_t* cs = (const f32x2_t*)(ws + WS_CS); bf16_t* qA = (bf16_t*)(ws + WS_QA);
    EPI_ROWLOOP {
      asm volatile("" ::: "memory"); const int row = u.pm * 256 + ai * 128 + wr * 64 + m * 16 + fr;
      const float sc = rsqrtf(sum4v(*(const f32x4*)(ssq + (size_t)row * 4)) * (1.f / 256.f) + EPS) * C2_96;
#pragma unroll
      for (int bj = 0; bj < 2; ++bj) {
        const int col = u.pn * 256 + bj * 128 + wc * 32 + 8 * fq; const int j = col % 96;
        f32x4 v0 = acc[ai][bj][m][0] * sc, v1 = acc[ai][bj][m][1] * sc;
        if (j >= 64) { const int i0 = (j - 64) >> 1;
          const f32x2_t c0 = cs[row * 16 + i0], c1 = cs[row * 16 + i0 + 1], c2 = cs[row * 16 + i0 + 2], c3 = cs[row * 16 + i0 + 3];
          f32x4 y0, y1;
          y0[0] = v0[0] * c0.x - v0[1] * c0.y; y0[1] = v0[1] * c0.x + v0[0] * c0.y;
          y0[2] = v0[2] * c1.x - v0[3] * c1.y; y0[3] = v0[3] * c1.x + v0[2] * c1.y;
          y1[0] = v1[0] * c2.x - v1[1] * c2.y; y1[1] = v1[1] * c2.x + v1[0] * c2.y;
          y1[2] = v1[2] * c3.x - v1[3] * c3.y; y1[3] = v1[3] * c3.x + v1[2] * c3.y;
          v0 = y0; v1 = y1; }
        *(u32x4*)(qA + (size_t)row * 768 + col) = pack8(v0, v1);
      }
    }
  }
};

struct EpiUkv { EPI_HEAD
  unsigned char* ws; int li;
  EPI_SIG { EPI_BEGIN
    const float* sskv = sskv_i(ws, li); bf16_t *kA = (bf16_t*)(ws + WS_KA), *vA = (bf16_t*)(ws + WS_VA);
    EPI_ROWLOOP {
      asm volatile("" ::: "memory"); const int row = u.pm * 256 + ai * 128 + wr * 64 + m * 16 + fr;
      const float sc = rsqrtf(sum4v(*(const f32x4*)(sskv + (size_t)row * 4)) * (1.f / 128.f) + EPS);
#pragma unroll
      for (int bj = 0; bj < 2; ++bj) {
        const int col = u.pn * 256 + bj * 128 + wc * 32 + 8 * fq; const int h = col >> 7, j = col & 127;
        bf16_t* dst = j < 64 ? kA + (size_t)row * 768 + h * 96 + j : vA + (size_t)row * 512 + h * 64 + (j - 64);
        *(u32x4*)dst = pack8(acc[ai][bj][m][0] * sc, acc[ai][bj][m][1] * sc);
      }
    }
  }
};

struct EpiResid { EPI_HEAD
  unsigned char* ws; int ssi;
  EPI_SIG { EPI_BEGIN
    bf16_t* hb = (bf16_t*)(ws + WS_HB); float* ssn = ssp_k(ws, ssi);
    EPI_ROWLOOP {
      asm volatile("" ::: "memory"); const int row = u.pm * 256 + ai * 128 + wr * 64 + m * 16 + fr;
      float sq = 0.f;
#pragma unroll
      for (int bj = 0; bj < 2; ++bj) {
        const size_t off = (size_t)row * 1024 + u.pn * 256 + bj * 128 + wc * 32 + 8 * fq;
        const u32x4 hv = *(const u32x4*)(hb + off);
        const f32x4 b0 = (f32x4){__uint_as_float(hv.x << 16), __uint_as_float(hv.x & 0xffff0000u), __uint_as_float(hv.y << 16), __uint_as_float(hv.y & 0xffff0000u)};
        const f32x4 b1 = (f32x4){__uint_as_float(hv.z << 16), __uint_as_float(hv.z & 0xffff0000u), __uint_as_float(hv.w << 16), __uint_as_float(hv.w & 0xffff0000u)};
        const f32x4 o0 = b0 + acc[ai][bj][m][0], o1 = b1 + acc[ai][bj][m][1];
        *(u32x4*)(hb + off) = pack8(o0, o1); sq += sq4(o0) + sq4(o1);
      }
      sq += __shfl_xor(sq, 16); sq += __shfl_xor(sq, 32);
      if (fq == 0) ssn[(size_t)row * 16 + u.pn * 4 + wc] = sq;
    }
  }
};

struct EpiSwiGLU { EPI_HEAD
  unsigned char* ws; int ssi;
  EPI_SIG { EPI_BEGIN
    const float* ss = ssp_k(ws, ssi); bf16_t* mid = (bf16_t*)(ws + WS_MID);
    EPI_ROWLOOP {
      asm volatile("" ::: "memory"); const int row = u.pm * 256 + ai * 128 + wr * 64 + m * 16 + fr;
      const float rstd = rsqrtf(sum16(ss + (size_t)row * 16) * (1.f / 1024.f) + EPS);
      f32x4 r[2];
#pragma unroll
      for (int n = 0; n < 2; ++n) { const f32x4 g = acc[ai][0][m][n] * rstd, up = acc[ai][1][m][n] * rstd;
#pragma unroll
        for (int e = 0; e < 4; ++e) r[n][e] = g[e] * __builtin_amdgcn_rcpf(1.f + ex2(-g[e] * LOG2E)) * up[e]; }
      *(u32x4*)(mid + (size_t)row * DFF + u.pn * 128 + wc * 32 + 8 * fq) = pack8(r[0], r[1]);
    }
  }
};

struct EpiOddQkv { EPI_HEAD
  unsigned char* ws; int ssi;
  EPI_SIG { EPI_BEGIN
    const int pn = u.pn;
    const float* ss = ssp_k(ws, ssi); bf16_t *q = (bf16_t*)(ws + WS_OQ), *k = (bf16_t*)(ws + WS_OK), *v = (bf16_t*)(ws + WS_OV);
    EPI_ROWLOOP {
      asm volatile("" ::: "memory"); const int row = u.pm * 256 + ai * 128 + wr * 64 + m * 16 + fr;
      const float rstd = rsqrtf(sum16(ss + (size_t)row * 16) * (1.f / 1024.f) + EPS);
#pragma unroll
      for (int bj = 0; bj < 2; ++bj) {
        const int ct = wc * 32 + 8 * fq;
        bf16_t* dst = pn < 4 ? q + (size_t)row * 1024 + pn * 256 + bj * 128 + ct : (bj == 0 ? k : v) + (size_t)row * 128 + ct;
        const float sc = pn < 4 ? rstd * C2_64 : rstd;
        *(u32x4*)dst = pack8(acc[ai][bj][m][0] * sc, acc[ai][bj][m][1] * sc);
      }
    }
  }
};

__device__ __forceinline__ unsigned cvtpk_s(float lo, float hi) { f32x2_t v = {lo, hi}; bf16x2_t b = __builtin_convertvector(v, bf16x2_t); return __builtin_bit_cast(unsigned, b); }
__device__ __forceinline__ s16x4 vtr(LAS const char* p) { return __builtin_bit_cast(s16x4, __builtin_amdgcn_ds_read_tr16_b64_v4i16((LAS v4i16_t*)p)); }
struct SoftState { float m, l, seen; f32x16 o0, o1, negm; };
#define ROFF(r) (((r) & 3) + 8 * ((r) >> 2))
__device__ __forceinline__ void soft_init(SoftState& st) { st.m = 0.f; st.l = 0.f; st.seen = 0.f; st.o0 = f32x16{}; st.o1 = f32x16{}; st.negm = f32x16{}; }

template <int DQK, int MODE, int PM = 0>
__device__ __forceinline__ void attn_subtile(SoftState& st, const bf16x8* qf, LAS const char* Ksub, int krs, LAS const char* Vsub, int vdh, int lane, bool do_mask, int a0, int a1, float f0) {
  const int r32 = lane & 31, hi = lane >> 5;
  f32x16 p0, p1;
  LAS const char* ka = Ksub + r32 * krs + hi * 16;
  bf16x8 kf0[DQK / 16], kf1[DQK / 16];
#pragma unroll
  for (int c = 0; c < DQK / 16; ++c) { kf0[c] = *(const LAS bf16x8*)(ka + c * 32); kf1[c] = *(const LAS bf16x8*)(ka + 32 * krs + c * 32); }
  __builtin_amdgcn_sched_barrier(0);
#pragma unroll
  for (int c = 0; c < DQK / 16; ++c) {
    p0 = __builtin_amdgcn_mfma_f32_32x32x16_bf16(kf0[c], qf[c], c == 0 ? st.negm : p0, 0, 0, 0);
    p1 = __builtin_amdgcn_mfma_f32_32x32x16_bf16(kf1[c], qf[c], c == 0 ? st.negm : p1, 0, 0, 0);
  }
  LAS const char* vb = Vsub + ((lane >> 4) & 1) * 32 + (lane & 3) * 8 + (4 * hi + ((lane & 15) >> 2)) * 64;
  s16x4 vl0[4], vh0[4], vl1[4], vh1[4];
#pragma unroll
  for (int kc = 0; kc < 4; ++kc) { vl0[kc] = vtr(vb + kc * 1024); vh0[kc] = vtr(vb + kc * 1024 + 512); vl1[kc] = vtr(vb + vdh + kc * 1024); vh1[kc] = vtr(vb + vdh + kc * 1024 + 512); }
  __builtin_amdgcn_sched_barrier(0);
  if (MODE == 1) {
    if (do_mask) {
#pragma unroll
      for (int r = 0; r < 16; ++r) { const int d0 = a0 - ROFF(r); if (d0 < 0) p0[r] = -INFINITY; if (d0 < 32) p1[r] = -INFINITY; }
    }
  } else if (MODE != 0) {
    const unsigned wmax = (MODE == 2) ? 128u : 127u; const float nf0 = -f0; const bool chk_k = a1 < 0;
#pragma unroll
    for (int r = 0; r < 16; ++r) {
      const int d0 = a0 - ROFF(r), d1 = d0 - 32;
      p0[r] = __builtin_fmaf(nf0, (float)d0, p0[r]); p1[r] = __builtin_fmaf(nf0, (float)d1, p1[r]);
    }
    if (do_mask) {
      if (chk_k) {
#pragma unroll
        for (int r = 0; r < 16; ++r) { const int d0 = a0 - ROFF(r), d1 = d0 - 32, k0i = a1 + ROFF(r), k1i = k0i + 32;
          if ((unsigned)d0 > wmax || k0i < 0) p0[r] = -INFINITY; if ((unsigned)d1 > wmax || k1i < 0) p1[r] = -INFINITY; }
      } else {
#pragma unroll
        for (int r = 0; r < 16; ++r) { const int d0 = a0 - ROFF(r), d1 = d0 - 32;
          if ((unsigned)d0 > wmax) p0[r] = -INFINITY; if ((unsigned)d1 > wmax) p1[r] = -INFINITY; }
      }
    }
  }
  float m0 = fmaxf(p0[0], p1[0]), m1 = fmaxf(p0[1], p1[1]), m2 = fmaxf(p0[2], p1[2]), m3 = fmaxf(p0[3], p1[3]);
#pragma unroll
  for (int r = 4; r < 16; r += 4) { m0 = fmaxf(m0, fmaxf(p0[r], p1[r])); m1 = fmaxf(m1, fmaxf(p0[r + 1], p1[r + 1])); m2 = fmaxf(m2, fmaxf(p0[r + 2], p1[r + 2])); m3 = fmaxf(m3, fmaxf(p0[r + 3], p1[r + 3])); }
  float mx = fmaxf(fmaxf(m0, m1), fmaxf(m2, m3));
  { auto rr = __builtin_amdgcn_permlane32_swap(__float_as_uint(mx), __float_as_uint(mx), false, false); mx = fmaxf(__uint_as_float(rr[0]), __uint_as_float(rr[1])); }
  const bool unset = st.seen == 0.f;
  float d = unset ? mx : fmaxf(mx, 0.f); d = (d == -INFINITY) ? 0.f : d;
  st.seen = (mx == -INFINITY) ? st.seen : 1.f;
  if (__builtin_amdgcn_ballot_w64(d != 0.f) != 0ull) {
    const float alpha = unset ? 1.f : ex2(-d);
    st.m += d;
#pragma unroll
    for (int r = 0; r < 16; ++r) { p0[r] -= d; p1[r] -= d; st.negm[r] = -st.m; }
    st.l *= alpha; st.o0 *= alpha; st.o1 *= alpha;
  }
  float s0 = 0.f, s1 = 0.f, s2 = 0.f, s3 = 0.f;
#pragma unroll
  for (int r = 0; r < 16; r += 4) {
    p0[r] = ex2(p0[r]); p1[r] = ex2(p1[r]); p0[r + 1] = ex2(p0[r + 1]); p1[r + 1] = ex2(p1[r + 1]); p0[r + 2] = ex2(p0[r + 2]); p1[r + 2] = ex2(p1[r + 2]); p0[r + 3] = ex2(p0[r + 3]); p1[r + 3] = ex2(p1[r + 3]);
    s0 += p0[r] + p1[r]; s1 += p0[r + 1] + p1[r + 1]; s2 += p0[r + 2] + p1[r + 2]; s3 += p0[r + 3] + p1[r + 3]; }
  st.l += (s0 + s1) + (s2 + s3);
  u32x4 pw[4];
#pragma unroll
  for (int q = 0; q < 2; ++q) {
    pw[q] = (u32x4){cvtpk_s(p0[8 * q], p0[8 * q + 1]), cvtpk_s(p0[8 * q + 2], p0[8 * q + 3]), cvtpk_s(p0[8 * q + 4], p0[8 * q + 5]), cvtpk_s(p0[8 * q + 6], p0[8 * q + 7])};
    pw[2 + q] = (u32x4){cvtpk_s(p1[8 * q], p1[8 * q + 1]), cvtpk_s(p1[8 * q + 2], p1[8 * q + 3]), cvtpk_s(p1[8 * q + 4], p1[8 * q + 5]), cvtpk_s(p1[8 * q + 6], p1[8 * q + 7])};
  }
#pragma unroll
  for (int kc = 0; kc < 4; ++kc) {
    const bf16x8 vf0 = (bf16x8){vl0[kc][0], vl0[kc][1], vl0[kc][2], vl0[kc][3], vh0[kc][0], vh0[kc][1], vh0[kc][2], vh0[kc][3]};
    const bf16x8 vf1 = (bf16x8){vl1[kc][0], vl1[kc][1], vl1[kc][2], vl1[kc][3], vh1[kc][0], vh1[kc][1], vh1[kc][2], vh1[kc][3]};
    const bf16x8 pb = __builtin_bit_cast(bf16x8, pw[kc]);
    st.o0 = __builtin_amdgcn_mfma_f32_32x32x16_bf16(vf0, pb, st.o0, 0, 0, 0);
    st.o1 = __builtin_amdgcn_mfma_f32_32x32x16_bf16(vf1, pb, st.o1, 0, 0, 0);
  }
}

__device__ __forceinline__ void attn_tile128(SoftState& st, const bf16x8* qf, LAS const char* Kt, int krs, LAS const char* Vt, int vdh, int lane) {
  const int r32 = lane & 31, hi = lane >> 5;
  f32x16 p[4];
  LAS const char* ka = Kt + r32 * krs + hi * 16;
#pragma unroll
  for (int h2 = 0; h2 < 2; ++h2) {
    bf16x8 kf0[6], kf1[6];
#pragma unroll
    for (int c = 0; c < 6; ++c) { kf0[c] = *(const LAS bf16x8*)(ka + (64 * h2) * krs + c * 32); kf1[c] = *(const LAS bf16x8*)(ka + (64 * h2 + 32) * krs + c * 32); }
    __builtin_amdgcn_sched_barrier(0);
#pragma unroll
    for (int c = 0; c < 6; ++c) {
      p[2 * h2] = __builtin_amdgcn_mfma_f32_32x32x16_bf16(kf0[c], qf[c], c == 0 ? st.negm : p[2 * h2], 0, 0, 0);
      p[2 * h2 + 1] = __builtin_amdgcn_mfma_f32_32x32x16_bf16(kf1[c], qf[c], c == 0 ? st.negm : p[2 * h2 + 1], 0, 0, 0);
    }
    __builtin_amdgcn_sched_barrier(0);
  }
  LAS const char* vb = Vt + ((lane >> 4) & 1) * 32 + (lane & 3) * 8 + (4 * hi + ((lane & 15) >> 2)) * 64;
  s16x4 vl0[4], vh0[4], vl1[4], vh1[4];
#pragma unroll
  for (int kc = 0; kc < 4; ++kc) { vl0[kc] = vtr(vb + kc * 1024); vh0[kc] = vtr(vb + kc * 1024 + 512); vl1[kc] = vtr(vb + vdh + kc * 1024); vh1[kc] = vtr(vb + vdh + kc * 1024 + 512); }
  __builtin_amdgcn_sched_barrier(0);
  float m0 = fmaxf(p[0][0], p[1][0]), m1 = fmaxf(p[0][1], p[1][1]), m2 = fmaxf(p[2][0], p[3][0]), m3 = fmaxf(p[2][1], p[3][1]);
#pragma unroll
  for (int r = 2; r < 16; r += 2) { m0 = fmaxf(m0, fmaxf(p[0][r], p[1][r])); m1 = fmaxf(m1, fmaxf(p[0][r + 1], p[1][r + 1])); m2 = fmaxf(m2, fmaxf(p[2][r], p[3][r])); m3 = fmaxf(m3, fmaxf(p[2][r + 1], p[3][r + 1])); }
  float mx = fmaxf(fmaxf(m0, m1), fmaxf(m2, m3));
  { auto rr = __builtin_amdgcn_permlane32_swap(__float_as_uint(mx), __float_as_uint(mx), false, false); mx = fmaxf(__uint_as_float(rr[0]), __uint_as_float(rr[1])); }
  const bool unset = st.seen == 0.f;
  float d = unset ? mx : fmaxf(mx, 0.f); d = (d == -INFINITY) ? 0.f : d;
  st.seen = (mx == -INFINITY) ? st.seen : 1.f;
  if (__builtin_amdgcn_ballot_w64(d != 0.f) != 0ull) {
    const float alpha = unset ? 1.f : ex2(-d);
    st.m += d;
#pragma unroll
    for (int r = 0; r < 16; ++r) { p[0][r] -= d; p[1][r] -= d; p[2][r] -= d; p[3][r] -= d; st.negm[r] = -st.m; }
    st.l *= alpha; st.o0 *= alpha; st.o1 *= alpha;
  }
  float s0 = 0.f, s1 = 0.f, s2 = 0.f, s3 = 0.f;
#pragma unroll
  for (int r = 0; r < 16; ++r) { p[0][r] = ex2(p[0][r]); p[1][r] = ex2(p[1][r]); p[2][r] = ex2(p[2][r]); p[3][r] = ex2(p[3][r]); s0 += p[0][r]; s1 += p[1][r]; s2 += p[2][r]; s3 += p[3][r]; }
  st.l += (s0 + s1) + (s2 + s3);
  u32x4 pw[8];
#pragma unroll
  for (int kb = 0; kb < 4; ++kb)
#pragma unroll
    for (int q = 0; q < 2; ++q)
      pw[2 * kb + q] = (u32x4){cvtpk_s(p[kb][8 * q], p[kb][8 * q + 1]), cvtpk_s(p[kb][8 * q + 2], p[kb][8 * q + 3]), cvtpk_s(p[kb][8 * q + 4], p[kb][8 * q + 5]), cvtpk_s(p[kb][8 * q + 6], p[kb][8 * q + 7])};
#pragma unroll
  for (int kc = 0; kc < 4; ++kc) {
    const bf16x8 vf0 = (bf16x8){vl0[kc][0], vl0[kc][1], vl0[kc][2], vl0[kc][3], vh0[kc][0], vh0[kc][1], vh0[kc][2], vh0[kc][3]};
    const bf16x8 vf1 = (bf16x8){vl1[kc][0], vl1[kc][1], vl1[kc][2], vl1[kc][3], vh1[kc][0], vh1[kc][1], vh1[kc][2], vh1[kc][3]};
    const bf16x8 pb = __builtin_bit_cast(bf16x8, pw[kc]);
    st.o0 = __builtin_amdgcn_mfma_f32_32x32x16_bf16(vf0, pb, st.o0, 0, 0, 0);
    st.o1 = __builtin_amdgcn_mfma_f32_32x32x16_bf16(vf1, pb, st.o1, 0, 0, 0);
    vl0[kc] = vtr(vb + (kc + 4) * 1024); vh0[kc] = vtr(vb + (kc + 4) * 1024 + 512); vl1[kc] = vtr(vb + vdh + (kc + 4) * 1024); vh1[kc] = vtr(vb + vdh + (kc + 4) * 1024 + 512);
  }
#pragma unroll
  for (int kc = 0; kc < 4; ++kc) {
    const bf16x8 vf0 = (bf16x8){vl0[kc][0], vl0[kc][1], vl0[kc][2], vl0[kc][3], vh0[kc][0], vh0[kc][1], vh0[kc][2], vh0[kc][3]};
    const bf16x8 vf1 = (bf16x8){vl1[kc][0], vl1[kc][1], vl1[kc][2], vl1[kc][3], vh1[kc][0], vh1[kc][1], vh1[kc][2], vh1[kc][3]};
    const bf16x8 pb = __builtin_bit_cast(bf16x8, pw[kc + 4]);
    st.o0 = __builtin_amdgcn_mfma_f32_32x32x16_bf16(vf0, pb, st.o0, 0, 0, 0);
    st.o1 = __builtin_amdgcn_mfma_f32_32x32x16_bf16(vf1, pb, st.o1, 0, 0, 0);
  }
}

__device__ __forceinline__ void attn_store(const SoftState& st, float l, bf16_t* Orow, int hi) {
  const float inv = 1.f / l;
#pragma unroll
  for (int g = 0; g < 4; ++g) {
    u32x2 w0, w1;
    w0.x = cvtpk_s(st.o0[4 * g] * inv, st.o0[4 * g + 1] * inv); w0.y = cvtpk_s(st.o0[4 * g + 2] * inv, st.o0[4 * g + 3] * inv);
    w1.x = cvtpk_s(st.o1[4 * g] * inv, st.o1[4 * g + 1] * inv); w1.y = cvtpk_s(st.o1[4 * g + 2] * inv, st.o1[4 * g + 3] * inv);
    *(u32x2*)(Orow + 8 * g + 4 * hi) = w0; *(u32x2*)(Orow + 32 + 8 * g + 4 * hi) = w1;
  }
}

constexpr int WK_RS = 144, WK_BYTES = 384 * WK_RS, WV_OFF = WK_BYTES, WV_DH = 384 * 64;
__device__ __forceinline__ void win_loadg(u32x4 (&kr)[6], u32x4 (&vr)[6], const bf16_t* Kg, int kpitch, const bf16_t* Vg, int vpitch, int r, int d, int b, int tid) {
#pragma unroll
  for (int i = 0; i < 6; ++i) { const int idx = tid + 512 * i, row = idx >> 3, ch = idx & 7; int j = 256 * b - 128 + row; j = j < 0 ? 0 : j; const size_t pos = (size_t)(r + d * j);
    kr[i] = *(const u32x4*)(Kg + pos * kpitch + ch * 8); vr[i] = *(const u32x4*)(Vg + pos * vpitch + ch * 8); }
}
__device__ __forceinline__ void win_stores(LAS unsigned char* lds, const u32x4 (&kr)[6], const u32x4 (&vr)[6], int tid) {
#pragma unroll
  for (int i = 0; i < 6; ++i) { const int idx = tid + 512 * i, row = idx >> 3, ch = idx & 7;
    *(LAS u32x4*)(lds + row * WK_RS + ch * 16) = kr[i]; *(LAS u32x4*)(lds + WV_OFF + (ch >> 2) * WV_DH + row * 64 + (ch & 3) * 16) = vr[i]; }
}
__device__ __forceinline__ void win_loadq(bf16x8 (&qf)[4], const bf16_t* Qg, int qpitch, int r, int d, int b, int wid, int lane) {
  const size_t pos = (size_t)(r + d * (256 * b + 32 * wid + (lane & 31)));
#pragma unroll
  for (int c = 0; c < 4; ++c) qf[c] = *(const bf16x8*)(Qg + pos * qpitch + 16 * c + 8 * (lane >> 5));
}
template <int MODE, bool SINK>
__device__ __forceinline__ void win_compute(LAS const unsigned char* lds, const bf16x8 (&qf)[4], bf16_t* Og, int opitch, float* lse, int lsepitch, int r, int d, int b, float slope2d, float sink2, int wid, int lane) {
  const int r32 = lane & 31, hi = lane >> 5;
  const size_t pos = (size_t)(r + d * (256 * b + 32 * wid + r32));
  SoftState st; soft_init(st);
  const int t0 = wid >> 1;
#pragma unroll 1
  for (int tt = 0; tt < 3; ++tt) { const int t = t0 + tt;
    if (256 * b - 128 + 64 * t + 63 < 0) continue;
    const int a0 = 32 * wid + r32 + 128 - 64 * t - 4 * hi, a1 = 256 * b - 128 + 64 * t + 4 * hi;
    attn_subtile<64, MODE>(st, qf, (LAS const char*)lds + 64 * t * WK_RS, WK_RS, (LAS const char*)lds + WV_OFF + 64 * t * 64, WV_DH, lane, tt != 1, a0, a1, slope2d);
  }
  float l = st.l + __shfl_xor(st.l, 32);
  if (SINK) l += ex2(sink2 - st.m);
  attn_store(st, l, Og + pos * opitch, hi);
  if (lse != nullptr && hi == 0) lse[pos * lsepitch] = st.m + __builtin_amdgcn_logf(l);
}

constexpr int MK_RS = 208, MK_BYTES = 128 * MK_RS, MV_DH = 128 * 64, MBUF = MK_BYTES + 2 * MV_DH;
template <int PM = 0>
__device__ __forceinline__ void mla_unit(LAS unsigned char* lds, const bf16_t* qA, const bf16_t* kA, const bf16_t* vA, bf16_t* ocat, int h, int qb, int tid, int wid, int lane) {
  const int r32 = lane & 31, hi = lane >> 5;
  const int q0 = 256 * qb, NT = 2 * qb + 2;
  const bf16_t* Kg = kA + h * 96; const bf16_t* Vg = vA + h * 64;
  const size_t pos = (size_t)(q0 + 32 * wid + r32);
  bf16x8 qf[6];
#pragma unroll
  for (int c = 0; c < 6; ++c) qf[c] = *(const bf16x8*)(qA + pos * 768 + h * 96 + 16 * c + 8 * hi);
  int kgo[4], vgo[2];
#pragma unroll
  for (int i = 0; i < 4; ++i) { const int c13 = 64 * (wid + 8 * i) + lane, row = c13 / 13; int ch = c13 - row * 13; ch = ch > 11 ? 11 : ch; kgo[i] = (row * 768 + ch * 8) * 2; }
#pragma unroll
  for (int i = 0; i < 2; ++i) { const int cv = 64 * (wid + 8 * i) + lane, dh = cv >> 9, row = (cv & 511) >> 2, c4 = cv & 3; vgo[i] = (row * 512 + (dh * 4 + c4) * 8) * 2; }
#define MLA_DMA(t, bufi) do { const char* kt_ = (const char*)(Kg + (size_t)(128 * (t)) * 768); const char* vt_ = (const char*)(Vg + (size_t)(128 * (t)) * 512); \
    _Pragma("unroll") for (int i = 0; i < 3; ++i) __builtin_amdgcn_global_load_lds((const unsigned*)(kt_ + kgo[i]), (LAS unsigned*)(lds + (bufi) * MBUF + (wid + 8 * i) * 1024), 16, 0, 0); \
    if (wid < 2) __builtin_amdgcn_global_load_lds((const unsigned*)(kt_ + kgo[3]), (LAS unsigned*)(lds + (bufi) * MBUF + (wid + 24) * 1024), 16, 0, 0); \
    _Pragma("unroll") for (int i = 0; i < 2; ++i) __builtin_amdgcn_global_load_lds((const unsigned*)(vt_ + vgo[i]), (LAS unsigned*)(lds + (bufi) * MBUF + MK_BYTES + (wid + 8 * i) * 1024), 16, 0, 0); } while (0)
  SoftState st; soft_init(st);
  MLA_DMA(0, 0);
  __syncthreads();
  const int qlo = q0 + 32 * wid;
#pragma unroll 1
  for (int t = 0; t < NT; ++t) {
    const int buf = t & 1;
    if (t + 1 < NT) MLA_DMA(t + 1, buf ^ 1);
    if (t < 2 * qb) {
      attn_tile128(st, qf, (LAS const char*)lds + buf * MBUF, MK_RS, (LAS const char*)lds + buf * MBUF + MK_BYTES, MV_DH, lane);
    } else {
#pragma unroll 1
      for (int sub = 0; sub < 2; ++sub) {
        const int kbase = 128 * t + 64 * sub;
        if (kbase > qlo + 31) continue;
        const bool need_mask = (kbase + 63 > qlo);
        const int a0 = (qlo + r32) - (kbase + 4 * hi);
        attn_subtile<96, 1, PM>(st, qf, (LAS const char*)lds + buf * MBUF + 64 * sub * MK_RS, MK_RS, (LAS const char*)lds + buf * MBUF + MK_BYTES + 64 * sub * 64, MV_DH, lane, need_mask, a0, 0, 0.f);
      }
    }
    __syncthreads();
  }
#undef MLA_DMA
  const float l = st.l + __shfl_xor(st.l, 32);
  attn_store(st, l, ocat + pos * 1024 + h * 64, hi);
}

__device__ __forceinline__ unsigned f2bf(float f) { unsigned u = __builtin_bit_cast(unsigned, f); return (u + 0x7fffu + ((u >> 16) & 1u)) >> 16; }
__device__ __forceinline__ unsigned pk2(float lo, float hi) { return f2bf(lo) | (f2bf(hi) << 16); }
__device__ __forceinline__ float wave_sum(float v) {
#pragma unroll
  for (int o = 1; o < 64; o <<= 1) v += __shfl_xor(v, o);
  return v;
}
template <class F>
__device__ __forceinline__ void tr_item(const float* W, int K, int Nsrc, const float* gk, bf16_t* WT, int Ndst, LAS float* scr, int item, int lane, F srccol) {
  (void)scr;
  const int nblk = Ndst / 64, kb = item / nblk, nb = item - kb * nblk, k0 = 64 * kb, n = 64 * nb + lane;
  const int sc = srccol(n);
  const float* src = W + (size_t)k0 * Nsrc + (sc >= 0 ? sc : 0);
  bf16_t* dst = WT + (size_t)n * K + k0;
#pragma unroll 1
  for (int c0 = 0; c0 < 8; c0 += 4) {
    float v[4][8];
#pragma unroll
    for (int cc = 0; cc < 4; ++cc)
#pragma unroll
      for (int e = 0; e < 8; ++e) v[cc][e] = __builtin_nontemporal_load(src + (size_t)(8 * (c0 + cc) + e) * Nsrc);
#pragma unroll
    for (int cc = 0; cc < 4; ++cc) {
      if (gk) {
#pragma unroll
        for (int e = 0; e < 8; ++e) v[cc][e] *= gk[k0 + 8 * (c0 + cc) + e];
      }
      if (sc < 0) {
#pragma unroll
        for (int e = 0; e < 8; ++e) v[cc][e] = 0.f;
      }
      u32x4 o; o.x = pk2(v[cc][0], v[cc][1]); o.y = pk2(v[cc][2], v[cc][3]); o.z = pk2(v[cc][4], v[cc][5]); o.w = pk2(v[cc][6], v[cc][7]);
      *(u32x4*)(dst + 8 * (c0 + cc)) = o;
    }
  }
}
struct ColId { __device__ int operator()(int n) const { return n; } };
struct ColWin { __device__ int operator()(int n) const { if (n < 384) return n; if (n < 416) { const int j = n - 384; return 384 + (j >> 1) + 16 * (j & 1); } if (n < 512) return -1; return n - 96; } };
struct ColUq { __device__ int operator()(int n) const { const int h = n / 96, j = n - h * 96; if (j < 64) return n; const int t = j - 64; return h * 96 + 64 + (t >> 1) + 16 * (t & 1); } };
struct ColGu { __device__ int operator()(int n) const { const int pn = n >> 8, t = n & 255; return t < 128 ? 128 * pn + t : DFF + 128 * pn + (t - 128); } };

__device__ __forceinline__ void convert_ffn(KPtr pk, int l, int w, int nw, int lane) {
  unsigned char* ws = pk->ws;
  constexpr int I_GU = 16 * 88, I_WD = 44 * 16, N_F = I_GU + I_WD;
  for (int r = w; r < N_F; r += nw) {
    if (r < I_GU) tr_item(pk->f_w_gate_up + (size_t)l * DM * 2 * DFF, DM, 2 * DFF, pk->ffn_norm + l * DM, (bf16_t*)(ws + WS_WGU) + (size_t)l * 2 * DFF * DM, 2 * DFF, (LAS float*)nullptr, r, lane, ColGu());
    else tr_item(pk->f_w_down + (size_t)l * DFF * DM, DFF, DM, nullptr, (bf16_t*)(ws + WS_WD) + (size_t)l * DM * DFF, DM, (LAS float*)nullptr, r - I_GU, lane, ColId());
  }
}

__device__ __forceinline__ void convert_mix1(KPtr pk, int w, int nw, int lane) {
  unsigned char* ws = pk->ws; constexpr int i = 1;
  constexpr int I_WIN = 16 * 32, I_UQ = 4 * 12, I_UKV = 2 * 16, I_EO = 16 * 16, I_OQ = 16 * 20, I_OO = 16 * 16, N_E = I_WIN + I_UQ + I_UKV + I_EO, N_O = I_OQ + I_OO;
  LAS float* scr = nullptr;
  for (int it = w; it < N_E + N_O; it += nw) { int r = it;
    if (r < I_WIN) { tr_item(pk->e_w_in + (size_t)i * DM * 1952, DM, 1952, pk->attn_norm + (2 * i) * DM, (bf16_t*)(ws + WS_WIN) + (size_t)i * 2048 * DM, 2048, scr, r, lane, ColWin()); continue; } r -= I_WIN;
    if (r < I_UQ) { tr_item(pk->e_w_uq + (size_t)i * 256 * 768, 256, 768, pk->e_q_norm + i * 256, (bf16_t*)(ws + WS_WUQ) + (size_t)i * 768 * 256, 768, scr, r, lane, ColUq()); continue; } r -= I_UQ;
    if (r < I_UKV) { tr_item(pk->e_w_ukv + (size_t)i * 128 * 1024, 128, 1024, pk->e_kv_norm + i * 128, (bf16_t*)(ws + WS_WUKV) + (size_t)i * 1024 * 128, 1024, scr, r, lane, ColId()); continue; } r -= I_UKV;
    if (r < I_EO) { tr_item(pk->e_w_out + (size_t)i * DM * DM, DM, DM, nullptr, (bf16_t*)(ws + WS_EWOUT) + (size_t)i * DM * DM, DM, scr, r, lane, ColId()); continue; } r -= I_EO;
    if (r < I_OQ) tr_item(pk->o_w_qkv + (size_t)i * DM * 1280, DM, 1280, pk->attn_norm + (2 * i + 1) * DM, (bf16_t*)(ws + WS_OQKV) + (size_t)i * 1280 * DM, 1280, scr, r, lane, ColId());
    else tr_item(pk->o_w_out + (size_t)i * DM * DM, DM, DM, nullptr, (bf16_t*)(ws + WS_OWOUT) + (size_t)i * DM * DM, DM, scr, r - I_OQ, lane, ColId());
  }
}

__device__ __forceinline__ void prologue(KPtr pk, LAS unsigned char* lds, int tid, int wid, int lane) {
  unsigned char* ws = pk->ws;
  const int G = gridDim.x, gw = blockIdx.x * 8 + wid, NGW = G * 8, gt = blockIdx.x * 512 + tid, NGT = G * 512;
  LAS float* scr = (LAS float*)(lds + wid * 8448);
  constexpr int I_WIN = 16 * 32, I_UQ = 4 * 12, I_UKV = 2 * 16, I_EO = 16 * 16, I_OQ = 16 * 20, I_OO = 16 * 16, I_GU = 16 * 88, I_WD = 44 * 16;
  constexpr int N_E = I_WIN + I_UQ + I_UKV + I_EO, N_O = I_OQ + I_OO, N_F = I_GU + I_WD;
  constexpr int NITEMS = N_E + N_O + N_F;
  for (int it = gw; it < NITEMS; it += NGW) {
    int r = it;
    if (r < N_F) { const int l = 0;
      if (r < I_GU) tr_item(pk->f_w_gate_up + (size_t)l * DM * 2 * DFF, DM, 2 * DFF, pk->ffn_norm + l * DM, (bf16_t*)(ws + WS_WGU) + (size_t)l * 2 * DFF * DM, 2 * DFF, scr, r, lane, ColGu());
      else tr_item(pk->f_w_down + (size_t)l * DFF * DM, DFF, DM, nullptr, (bf16_t*)(ws + WS_WD) + (size_t)l * DM * DFF, DM, scr, r - I_GU, lane, ColId());
      continue; }
    r -= N_F;
    if (r < N_E) { const int i = 0;
      if (r < I_WIN) { tr_item(pk->e_w_in + (size_t)i * DM * 1952, DM, 1952, pk->attn_norm + (2 * i) * DM, (bf16_t*)(ws + WS_WIN) + (size_t)i * 2048 * DM, 2048, scr, r, lane, ColWin()); continue; } r -= I_WIN;
      if (r < I_UQ) { tr_item(pk->e_w_uq + (size_t)i * 256 * 768, 256, 768, pk->e_q_norm + i * 256, (bf16_t*)(ws + WS_WUQ) + (size_t)i * 768 * 256, 768, scr, r, lane, ColUq()); continue; } r -= I_UQ;
      if (r < I_UKV) { tr_item(pk->e_w_ukv + (size_t)i * 128 * 1024, 128, 1024, pk->e_kv_norm + i * 128, (bf16_t*)(ws + WS_WUKV) + (size_t)i * 1024 * 128, 1024, scr, r, lane, ColId()); continue; } r -= I_UKV;
      tr_item(pk->e_w_out + (size_t)i * DM * DM, DM, DM, nullptr, (bf16_t*)(ws + WS_EWOUT) + (size_t)i * DM * DM, DM, scr, r, lane, ColId());
      continue; }
    r -= N_E;
    { const int i = 0;
      if (r < I_OQ) tr_item(pk->o_w_qkv + (size_t)i * DM * 1280, DM, 1280, pk->attn_norm + (2 * i + 1) * DM, (bf16_t*)(ws + WS_OQKV) + (size_t)i * 1280 * DM, 1280, scr, r, lane, ColId());
      else tr_item(pk->o_w_out + (size_t)i * DM * DM, DM, DM, nullptr, (bf16_t*)(ws + WS_OWOUT) + (size_t)i * DM * DM, DM, scr, r - I_OQ, lane, ColId()); }
  }
  float* ss0 = ssp_k(ws, 0);
  bf16_t* hb = (bf16_t*)(ws + WS_HB);
  for (int m = gw; m < S_; m += 2 * NGW) {
    const int m2 = m + NGW;
    const bool has2 = m2 < S_;
    const f32x4* xr = (const f32x4*)(pk->x + (size_t)m * DM) + lane; const f32x4* xr2 = (const f32x4*)(pk->x + (size_t)(has2 ? m2 : m) * DM) + lane;
    f32x4 v[4], w[4]; float s = 0.f, s2 = 0.f;
#pragma unroll
    for (int j = 0; j < 4; ++j) { v[j] = __builtin_nontemporal_load(xr + 64 * j); w[j] = __builtin_nontemporal_load(xr2 + 64 * j); }
#pragma unroll
    for (int j = 0; j < 4; ++j) { s += sq4(v[j]); s2 += sq4(w[j]); }
    s = wave_sum(s); s2 = wave_sum(s2);
    u32x2* o8 = (u32x2*)(hb + (size_t)m * DM) + lane;
#pragma unroll
    for (int j = 0; j < 4; ++j) { u32x2 q; q.x = pk2(v[j][0], v[j][1]); q.y = pk2(v[j][2], v[j][3]); o8[64 * j] = q; }
    if (lane < 16) ss0[(size_t)m * 16 + lane] = lane == 0 ? s : 0.f;
    if (has2) {
      u32x2* o82 = (u32x2*)(hb + (size_t)m2 * DM) + lane;
#pragma unroll
      for (int j = 0; j < 4; ++j) { u32x2 q; q.x = pk2(w[j][0], w[j][1]); q.y = pk2(w[j][2], w[j][3]); o82[64 * j] = q; }
      if (lane < 16) ss0[(size_t)m2 * 16 + lane] = lane == 0 ? s2 : 0.f;
    }
  }
  f32x2_t* cs = (f32x2_t*)(ws + WS_CS);
  for (int i = gt; i < S_ * 16; i += NGT) { const int pos = i >> 4, k = i & 15;
    const float inv_freq = exp2f(-(float)k * (13.287712379549449f / 16.f));
    const float ang = (float)pos * inv_freq;
    const float n = rintf(ang * 0.15915494309189535f);
    float rr = fmaf(-n, 6.28125f, ang); rr = fmaf(-n, 0.0019353071795864769f, rr);
    cs[i] = (f32x2_t){__cosf(rr), __sinf(rr)}; }
}

__device__ __forceinline__ void dil_merge(const bf16_t* dpart, const float* lse, bf16_t* ocat, int gt, int NGT) {
  for (int idx = gt; idx < S_ * 64; idx += NGT) { const int pos = idx >> 6, c = idx & 63, h = c >> 3;
    const float l0 = lse[(size_t)pos * 8 + h], l1 = lse[((size_t)S_ + pos) * 8 + h], l2 = lse[((size_t)2 * S_ + pos) * 8 + h];
    const float mx = fmaxf(l0, fmaxf(l1, l2)); float w0 = ex2(l0 - mx), w1 = ex2(l1 - mx), w2 = ex2(l2 - mx); const float inv = 1.f / (w0 + w1 + w2); w0 *= inv; w1 *= inv; w2 *= inv;
    const u32x4 a = *(const u32x4*)(dpart + (size_t)pos * 512 + c * 8), b = *(const u32x4*)(dpart + ((size_t)S_ + pos) * 512 + c * 8), d = *(const u32x4*)(dpart + ((size_t)2 * S_ + pos) * 512 + c * 8);
    u32x4 o;
#pragma unroll
    for (int e = 0; e < 4; ++e) {
      const float alo = __uint_as_float(a[e] << 16), ahi = __uint_as_float(a[e] & 0xffff0000u), blo = __uint_as_float(b[e] << 16), bhi = __uint_as_float(b[e] & 0xffff0000u), dlo = __uint_as_float(d[e] << 16), dhi = __uint_as_float(d[e] & 0xffff0000u);
      o[e] = pk2(w0 * alo + w1 * blo + w2 * dlo, w0 * ahi + w1 * bhi + w2 * dhi); }
    *(u32x4*)(ocat + (size_t)pos * 1024 + 512 + c * 8) = o; }
}


#ifdef NO_GEMM
#define GEMMCALL(...) do{}while(0)
#else
#define GEMMCALL(...) __VA_ARGS__
#endif
#if defined(NO_GEMM) || (defined(ONLY_G) && ONLY_G != 0)
#define GEMMCALL0(...) do{}while(0)
#else
#define GEMMCALL0(...) __VA_ARGS__
#endif
#if defined(NO_GEMM) || (defined(ONLY_G) && ONLY_G != 1)
#define GEMMCALL1(...) do{}while(0)
#else
#define GEMMCALL1(...) __VA_ARGS__
#endif
#if defined(NO_GEMM) || (defined(ONLY_G) && ONLY_G != 2)
#define GEMMCALL2(...) do{}while(0)
#else
#define GEMMCALL2(...) __VA_ARGS__
#endif
#if defined(NO_GEMM) || (defined(ONLY_G) && ONLY_G != 3)
#define GEMMCALL3(...) do{}while(0)
#else
#define GEMMCALL3(...) __VA_ARGS__
#endif
#if defined(NO_GEMM) || (defined(ONLY_G) && ONLY_G != 4)
#define GEMMCALL4(...) do{}while(0)
#else
#define GEMMCALL4(...) __VA_ARGS__
#endif
#if defined(NO_GEMM) || (defined(ONLY_G) && ONLY_G != 5)
#define GEMMCALL5(...) do{}while(0)
#else
#define GEMMCALL5(...) __VA_ARGS__
#endif
#if defined(NO_GEMM) || (defined(ONLY_G) && ONLY_G != 6)
#define GEMMCALL6(...) do{}while(0)
#else
#define GEMMCALL6(...) __VA_ARGS__
#endif
#ifdef NO_WIN
#define WINCALL(...) do{}while(0)
#else
#define WINCALL(...) __VA_ARGS__
#endif
#ifdef NO_MLA
#define MLACALL(...) do{}while(0)
#else
#define MLACALL(...) __VA_ARGS__
#endif
#ifdef NO_PRO
#define PROCALL(...) do{}while(0)
#else
#define PROCALL(...) __VA_ARGS__
#endif

#define RLX_AGENT __ATOMIC_RELAXED, __HIP_MEMORY_SCOPE_AGENT
#define XB_TMO      128
#define XB_XCNT(j)  (256  + 64 * (j))
#define XB_XSUB(j)  (1280 + 64 * (j))
#define XB_XGEN(j)  (2304 + 64 * (j))
#define XB_TOP      3328
#define XB_TOPGEN   3392
#define XCD_BAR_WORDS 3456
#define XB_SPIN_CAP (1u << 18)

__device__ __forceinline__ unsigned xb_ld(unsigned* p)              { return __hip_atomic_load(p, __ATOMIC_RELAXED, __HIP_MEMORY_SCOPE_AGENT); }
__device__ __forceinline__ unsigned xb_add(unsigned* p, unsigned v) { return __hip_atomic_fetch_add(p, v, __ATOMIC_RELAXED, __HIP_MEMORY_SCOPE_AGENT); }
__device__ __forceinline__ unsigned xb_xcc_id() { return (unsigned)__builtin_amdgcn_s_getreg((3 << 11) | 20) & 0xFu; }
#define XB_SPIN(cond, bar) do { unsigned _sp = 0; while (cond) { __builtin_amdgcn_s_sleep(1); \
    if ((++_sp & 255u) == 0u) { if (xb_ld(&(bar)[XB_TMO])) break; if (_sp > XB_SPIN_CAP) { atomicAdd(&(bar)[XB_TMO], 1u); break; } } } } while (0)

struct XcdBarrier {
    unsigned* bar; unsigned x;
    volatile LAS unsigned* st;
};

__device__ __forceinline__ XcdBarrier xcd_barrier_post(unsigned* bar, volatile LAS unsigned* st) {
    XcdBarrier b; b.bar = bar; b.x = xb_xcc_id(); b.st = st;
    if (threadIdx.x == 0) (void)xb_add(&bar[XB_XCNT(b.x)], 1u);
    return b;
}
__device__ __forceinline__ void xcd_barrier_complete(unsigned* bar, unsigned x, unsigned& nloc, unsigned& nx) {
    const unsigned G = gridDim.x * gridDim.y * gridDim.z;
    unsigned sum, cnt, mine, sp = 0u;
    for (;;) {
        sum = 0u; cnt = 0u; mine = 0u;
#pragma unroll
        for (unsigned j = 0; j < 16; ++j) { const unsigned c = xb_ld(&bar[XB_XCNT(j)]); sum += c; cnt += (c > 0u) ? 1u : 0u; mine = (j == x) ? c : mine; }
        if (sum == G) break;
        __builtin_amdgcn_s_sleep(1);
        if ((++sp & 255u) == 0u) { if (xb_ld(&bar[XB_TMO])) break; if (sp > XB_SPIN_CAP) { atomicAdd(&bar[XB_TMO], 1u); break; } }
    }
    nloc = mine > 0u ? mine : 1u; nx = cnt > 0u ? cnt : 1u;
}

__device__ __forceinline__ void xcd_barrier(const XcdBarrier& b) {
    asm volatile("s_waitcnt vmcnt(0)" ::: "memory");
    __syncthreads();
    if (threadIdx.x == 0) {
        unsigned* bar = b.bar;
        __builtin_amdgcn_s_waitcnt(0);
        unsigned nloc = b.st[0], nx = b.st[1];
        if (nloc == 0u) { xcd_barrier_complete(bar, b.x, nloc, nx); b.st[0] = nloc; b.st[1] = nx; }
        const unsigned old = xb_add(&bar[XB_XSUB(b.x)], 1u);
        const unsigned gen = old / nloc;
        if (old + 1u == (gen + 1u) * nloc) {
            __builtin_amdgcn_fence(__ATOMIC_RELEASE, "agent");
            asm volatile("s_waitcnt vmcnt(0)" ::: "memory");
            const unsigned og = xb_add(&bar[XB_TOP], 1u);
            const unsigned tg = og / nx;
            if (og + 1u == (tg + 1u) * nx) xb_add(&bar[XB_TOPGEN], 1u);
            else XB_SPIN(xb_ld(&bar[XB_TOPGEN]) == tg, bar);
            __builtin_amdgcn_fence(__ATOMIC_ACQUIRE, "agent");
            xb_add(&bar[XB_XGEN(b.x)], 1u);
            asm volatile("s_waitcnt vmcnt(0)" ::: "memory");
        } else {
            XB_SPIN(xb_ld(&bar[XB_XGEN(b.x)]) == gen, bar);
            __builtin_amdgcn_fence(__ATOMIC_ACQUIRE, "agent");
            asm volatile("s_waitcnt vmcnt(0)" ::: "memory");
        }
    }
    __syncthreads();
}

#ifndef REP_MLA
#define REP_MLA 1
#endif
#ifndef REP_GU
#define REP_GU 1
#endif
#ifndef REP_WIN
#define REP_WIN 1
#endif
#ifndef REP_PRO
#define REP_PRO 1
#endif
#ifndef REP_SYNC
#define REP_SYNC 1
#endif
#define GSYNC() do { _Pragma("unroll 1") for (int rs_ = 0; rs_ < REP_SYNC; ++rs_) { KPtr pb_ = (KPtr)__builtin_amdgcn_kernarg_segment_ptr(); asm volatile("" : "+s"(pb_)); XcdBarrier xb_; xb_.bar = (unsigned*)(pb_->ws + WS_BAR); xb_.x = xb_xcc_id(); xb_.st = (volatile LAS unsigned*)(lds + XB_LDS_OFF); xcd_barrier(xb_); } } while (0)
__global__ void __launch_bounds__(512, 2) mega_fwd(Params p) {
  extern __shared__ __attribute__((aligned(16))) unsigned char lds_raw[];
  LAS unsigned char* lds = (LAS unsigned char*)lds_raw;
  cg::grid_group grid = cg::this_grid();
  int wid0 = __builtin_amdgcn_readfirstlane(threadIdx.x >> 6); asm volatile("" : "+s"(wid0));
  if (threadIdx.x < 2) ((volatile LAS unsigned*)(lds + XB_LDS_OFF))[threadIdx.x] = 0u;
  __syncthreads();
  { KPtr pb_ = (KPtr)__builtin_amdgcn_kernarg_segment_ptr(); (void)xcd_barrier_post((unsigned*)(pb_->ws + WS_BAR), (volatile LAS unsigned*)(lds + XB_LDS_OFF)); }
#define FRESH() KPtr pp = (KPtr)__builtin_amdgcn_kernarg_segment_ptr(); asm volatile("" : "+s"(pp)); unsigned char* ws = pp->ws; \
  int w0_ = wid0; asm volatile("" : "+s"(w0_)); int ln0_; asm volatile("v_mbcnt_lo_u32_b32 %0, -1, 0\n\tv_mbcnt_hi_u32_b32 %0, -1, %0" : "=v"(ln0_)); int tid_ = w0_ * 64 + ln0_; const int lane_ = tid_ & 63; const int wid_ = __builtin_amdgcn_readfirstlane(tid_ >> 6); (void)lane_; (void)wid_; \
  int bx = blockIdx.x; asm volatile("" : "+s"(bx)); int G = gridDim.x; asm volatile("" : "+s"(G)); \

#define WSB(off) ((bf16_t*)(ws + (off)))

  _Pragma("unroll 1") for (int rep = 0; rep < REP_PRO; ++rep) { FRESH(); PROCALL(prologue(pp, lds, tid_, wid_, lane_)); }
  { KPtr pz_ = (KPtr)__builtin_amdgcn_kernarg_segment_ptr(); asm volatile("" : "+s"(pz_)); if (pz_->ws == nullptr) grid.sync(); }
  GSYNC();

#pragma unroll 1
  for (int layer = 0; layer < 4; ++layer) {
    const int i = layer >> 1;
    const int G0 = gridDim.x, bx0 = blockIdx.x; (void)G0; (void)bx0;
    if ((layer & 1) == 0) {
      { FRESH();
        pg8::Gemm g{WSB(WS_HB), WSB(WS_WIN) + (size_t)i * 2048 * DM, S_, 2048, DM}; pg8::StaticOrder SO; SO.init(S_, 2048, G, bx);
        EpiEvenIn E{ws, layer};
        GEMMCALL0(pg8::gemm_phase<EpiEvenIn, pg8::StaticOrder, true, true>(lds, g, SO, E, tid_)); }
      GSYNC();
      { FRESH();
        pg8::Gemm g{WSB(WS_CQ), WSB(WS_WUQ) + (size_t)i * 768 * 256, S_, 768, 256}; pg8::StaticOrder SO; SO.init(S_, 768, G, bx);
        EpiUq E{ws, i};
        GEMMCALL1(pg8::gemm_phase<EpiUq, pg8::StaticOrder, true, true>(lds, g, SO, E, tid_)); }
      { FRESH();
        pg8::Gemm g{WSB(WS_CKV), WSB(WS_WUKV) + (size_t)i * 1024 * 128, S_, 1024, 128}; pg8::StaticOrder SO; SO.init(S_, 1024, G, bx);
        EpiUkv E{ws, i};
        GEMMCALL2(pg8::gemm_phase<EpiUkv, pg8::StaticOrder, true, true>(lds, g, SO, E, tid_)); }
      {
#define DIL_DECODE(un) const int pat = ((un) % 1536) >> 9, rem = (un) & 511, h = rem >> 6, blk = rem & 63; \
        const int d = pat == 0 ? 1 : (pat == 1 ? 4 : 16); const int bpr = 64 / d; const int r = blk / bpr, b = blk - r * bpr;
        u32x4 kr[6], vr[6]; bf16x8 qn[4];
        { FRESH(); DIL_DECODE(bx0); win_loadg(kr, vr, WSB(WS_KB) + h * 64, 512, WSB(WS_VB) + h * 64, 512, r, d, b, tid_); win_loadq(qn, WSB(WS_QB) + h * 64, 512, r, d, b, wid_, lane_); }
#pragma unroll 1
        for (int un = bx0; un < 1536 * REP_WIN; un += G0) {
          FRESH();
          win_stores(lds, kr, vr, tid_);
          bf16x8 qf[4];
#pragma unroll
          for (int q_ = 0; q_ < 4; ++q_) qf[q_] = qn[q_];
          __syncthreads();
          if (un + G0 < 1536 * REP_WIN) { DIL_DECODE(un + G0); win_loadg(kr, vr, WSB(WS_KB) + h * 64, 512, WSB(WS_VB) + h * 64, 512, r, d, b, tid_); win_loadq(qn, WSB(WS_QB) + h * 64, 512, r, d, b, wid_, lane_); }
          DIL_DECODE(un);
          const float slope2d = exp2f(-(float)(h + 1)) * LOG2E * (float)d;
          WINCALL(win_compute<2, false>(lds, qf, WSB(WS_DPART) + (size_t)pat * S_ * 512 + h * 64, 512, (float*)(ws + WS_LSE) + (size_t)pat * S_ * 8 + h, 8, r, d, b, slope2d, 0.f, wid_, lane_));
          __syncthreads();
        }
#undef DIL_DECODE
      }
      GSYNC();
#pragma unroll 1
      for (int v = bx0; v < 512 * REP_MLA; v += G0) {
        FRESH(); const int vv = v & 511, h = vv & 7, s = (vv >> 3) & 31, qb = vv < 256 ? 63 - s : s;
        MLACALL(mla_unit(lds, WSB(WS_QA), WSB(WS_KA), WSB(WS_VA), WSB(WS_OCAT), h, qb, tid_, wid_, lane_));
      }
      { FRESH(); dil_merge(WSB(WS_DPART), (const float*)(ws + WS_LSE), WSB(WS_OCAT), bx * 512 + tid_, G * 512); }
      GSYNC();
    } else {
      { FRESH();
        pg8::Gemm g{WSB(WS_HB), WSB(WS_OQKV) + (size_t)i * 1280 * DM, S_, 1280, DM}; pg8::StaticOrder SO; SO.init(S_, 1280, G, bx);
        EpiOddQkv E{ws, 2 * layer};
        GEMMCALL3(pg8::gemm_phase<EpiOddQkv, pg8::StaticOrder, true, true>(lds, g, SO, E, tid_)); }
      if (layer == 1) { FRESH();
        const int nwg = (S_ / 256) * (1280 / 256), busy = nwg % G;
        if (busy == 0) convert_mix1(pp, bx * 8 + wid_, G * 8, lane_);
        else if (bx >= busy) convert_mix1(pp, (bx - busy) * 8 + wid_, (G - busy) * 8, lane_); }
      GSYNC();
#pragma unroll 1
      for (int un = bx0; un < 256 * REP_WIN; un += G0) {
        FRESH();
        const int kvh = (un & 255) >> 7, rem = un & 127, b = rem >> 1, qg = rem & 1;
        { u32x4 kr[6], vr[6]; win_loadg(kr, vr, WSB(WS_OK) + kvh * 64, 128, WSB(WS_OV) + kvh * 64, 128, 0, 1, b, tid_); win_stores(lds, kr, vr, tid_); }
        __syncthreads();
        bf16x8 qn[4]; win_loadq(qn, WSB(WS_OQ) + (kvh * 8 + qg * 4) * 64, 1024, 0, 1, b, wid_, lane_);
#pragma unroll 1
        for (int e = 0; e < 4; ++e) { const int qh = kvh * 8 + qg * 4 + e;
          bf16x8 qf[4];
#pragma unroll
          for (int q_ = 0; q_ < 4; ++q_) qf[q_] = qn[q_];
          if (e < 3) win_loadq(qn, WSB(WS_OQ) + (qh + 1) * 64, 1024, 0, 1, b, wid_, lane_);
          const float slope2d = exp2f(-0.5f * (float)(qh + 1)) * LOG2E;
          const float sink2 = pp->o_sinks[i * 16 + qh] * LOG2E;
          WINCALL(win_compute<3, true>(lds, qf, WSB(WS_OCAT) + qh * 64, 1024, nullptr, 0, 0, 1, b, slope2d, sink2, wid_, lane_)); }
        __syncthreads();
      }
      GSYNC();
    }
    { FRESH();
      const bf16_t* wt = (layer & 1) == 0 ? WSB(WS_EWOUT) + (size_t)i * DM * DM : WSB(WS_OWOUT) + (size_t)i * DM * DM;
      pg8::Gemm g{WSB(WS_OCAT), wt, S_, DM, DM}; pg8::StaticOrder SO; SO.init(S_, DM, G, bx);
      EpiResid E{ws, 2 * layer + 1};
      GEMMCALL4(pg8::gemm_phase<EpiResid, pg8::StaticOrder, true, true>(lds, g, SO, E, tid_)); }
    GSYNC();
    { FRESH();
      pg8::Gemm g{WSB(WS_HB), WSB(WS_WGU) + (size_t)layer * 2 * DFF * DM, S_, 2 * DFF, DM}; pg8::StaticOrder SO; SO.init(S_, 2 * DFF, G, bx);
      EpiSwiGLU E{ws, 2 * layer + 1};
      GEMMCALL5(pg8::gemm_phase<EpiSwiGLU, pg8::StaticOrder, true, true>(lds, g, SO, E, tid_)); }
    if (layer < 3) { FRESH();
      const int nwg = (S_ / 256) * (2 * DFF / 256), busy = nwg % G;
      if (busy == 0) convert_ffn(pp, layer + 1, bx * 8 + wid_, G * 8, lane_);
      else if (bx >= busy) convert_ffn(pp, layer + 1, (bx - busy) * 8 + wid_, (G - busy) * 8, lane_); }
#ifdef DUP_GU
    GSYNC();
    { FRESH();
      pg8::Gemm g{WSB(WS_HB), WSB(WS_WGU) + (size_t)layer * 2 * DFF * DM, S_, 2 * DFF, DM}; pg8::StaticOrder SO; SO.init(S_, 2 * DFF, G, bx);
      EpiSwiGLU E{ws, 2 * layer + 1};
      pg8::gemm_phase<EpiSwiGLU, pg8::StaticOrder, true, true>(lds, g, SO, E, tid_); }
#endif
    GSYNC();
    { FRESH();
      pg8::Gemm g{WSB(WS_MID), WSB(WS_WD) + (size_t)layer * DM * DFF, S_, DM, DFF}; pg8::StaticOrder SO; SO.init(S_, DM, G, bx);
      EpiResid E{ws, 2 * layer + 2};
      GEMMCALL6(pg8::gemm_phase<EpiResid, pg8::StaticOrder, true, true>(lds, g, SO, E, tid_)); }
    GSYNC();
  }
  { FRESH(); const float* ss8 = ssp_k(ws, 8); const int gw = bx * 8 + wid_, NGW = G * 8;
    f32x4 gv[4];
#pragma unroll
    for (int j = 0; j < 4; ++j) gv[j] = ((const f32x4*)pp->final_norm)[lane_ + 64 * j];
    const bf16_t* hbp = WSB(WS_HB);
    for (int m = gw; m < S_; m += NGW) { const float rstd = rsqrtf(sum16(ss8 + (size_t)m * 16) * (1.f / 1024.f) + EPS);
      const u32x2* hr = (const u32x2*)(hbp + (size_t)m * DM) + lane_; f32x4* o = (f32x4*)(pp->out + (size_t)m * DM) + lane_;
#pragma unroll
      for (int j = 0; j < 4; ++j) { const u32x2 w = hr[64 * j];
        const f32x4 hv = (f32x4){__uint_as_float(w.x << 16), __uint_as_float(w.x & 0xffff0000u), __uint_as_float(w.y << 16), __uint_as_float(w.y & 0xffff0000u)};
        __builtin_nontemporal_store(hv * rstd * gv[j], o + 64 * j); } } }
}

extern "C" void kernel_launch(void* const* d_in, const int* in_sizes, int n_in, void* d_out, int out_size, void* d_ws, size_t ws_size, hipStream_t stream) {
  static int grid = 0;
  if (grid == 0) {
    if (n_in != 15 || ws_size < WS_END) { fprintf(stderr, "kernel_launch: need 15 inputs and %zu bytes of workspace (got %d, %zu)\n", (size_t)WS_END, n_in, ws_size); grid = -1; return; }
    int dev = 0, cus = 0, per_cu = 0;
    hipGetDevice(&dev); hipDeviceGetAttribute(&cus, hipDeviceAttributeMultiprocessorCount, dev);
    hipFuncSetAttribute((const void*)mega_fwd, hipFuncAttributeMaxDynamicSharedMemorySize, LDS_BYTES);
    hipOccupancyMaxActiveBlocksPerMultiprocessor(&per_cu, (const void*)mega_fwd, 512, LDS_BYTES);
    if (per_cu < 1) { fprintf(stderr, "kernel_launch: occupancy query gave %d\n", per_cu); per_cu = 1; }
    (void)hipGetLastError();
    grid = cus;
  }
  if (grid < 0) return;
  if (hipMemsetAsync((char*)d_ws + WS_BAR, 0, 16384, stream) != hipSuccess) { fprintf(stderr, "memset failed\n"); return; }
  Params p{};
  const float** pp = (const float**)&p;
  for (int i = 0; i < 15; ++i) pp[i] = (const float*)d_in[i];
  p.out = (float*)d_out; p.ws = (unsigned char*)d_ws;
  void* args[] = {&p};
  hipError_t e = hipLaunchCooperativeKernel((const void*)mega_fwd, dim3(grid), dim3(512), args, LDS_BYTES, stream);
  if (e != hipSuccess) fprintf(stderr, "cooperative launch failed: %s (grid %d)\n", hipGetErrorString(e), grid);
}
```

```cpp
#include <hip/hip_runtime.h>
#include <hip/hip_cooperative_groups.h>
#include <cstdio>
#include <cstdint>
namespace cg = cooperative_groups;
namespace pg8 {
#define PG8_LAS __attribute__((address_space(3)))
typedef unsigned short bf16_t;
typedef short bf16x8 __attribute__((ext_vector_type(8)));
typedef float f32x4 __attribute__((ext_vector_type(4)));
typedef unsigned u32x4 __attribute__((ext_vector_type(4)));
constexpr int BM = 256, BK = 64, HALF = 128, HTB = HALF * BK * 2  , STAGE_BYTES = 8 * HTB, NXCD = 8, WGM = 8;

__host__ __device__ __forceinline__ int lds_byte(int r, int c) { const int st = (r >> 4) * 2 + (c >> 5), rr = r & 15, cc = c & 31, ob = rr * 64 + cc * 2; return st * 1024 + (ob ^ (((ob >> 9) & 1) << 5)); }
__host__ __device__ __forceinline__ void stage_rc(int b, int& R, int& C) { const int st = b / 1024, sb = b % 1024, swz = sb ^ (((sb >> 9) & 1) << 5); R = (st >> 1) * 16 + swz / 64; C = (st & 1) * 32 + (swz % 64) / 2; }
__host__ __device__ __forceinline__ int perm32(int rho) { const int n = rho >> 4, i = rho & 15; return 8 * (i >> 2) + 4 * n + (i & 3); }

struct Unit { int pm, pn; };
struct Gemm { const bf16_t* A; const bf16_t* Bt; int M, N, K; };

struct StaticOrder {
    int nM, nN, nwg, G, c;
    __host__ __device__ void init(int M, int N, int G_, int c_) { nM = M / BM; nN = N / BM; nwg = nM * nN; G = G_; c = c_; }
    __host__ __device__ bool next(int i, Unit& u) const {
        const long L = (long)i * G + c; if (L >= nwg) return false;
        int wgid = (int)L; { const int q = nwg / NXCD, r = nwg % NXCD, xcd = wgid % NXCD, off = wgid / NXCD; wgid = (xcd < r ? xcd * (q + 1) : r * (q + 1) + (xcd - r) * q) + off; }
        const int nig = WGM * nN, gid = wgid / nig, fm = gid * WGM, gsz = (nM - fm) < WGM ? (nM - fm) : WGM;
        u.pm = fm + ((wgid % nig) % gsz); u.pn = (wgid % nig) / gsz; return true;
    }
    __device__ __forceinline__ void a_ready(const Unit&) const {}
    __device__ __forceinline__ void done(const Unit&) const {}
};

__device__ __forceinline__ unsigned cvt_pk_bf16(float lo, float hi) { unsigned r; asm volatile("v_cvt_pk_bf16_f32 %0, %1, %2" : "=v"(r) : "v"(lo), "v"(hi)); return r; }
template <class Epi, class Sched, bool ALIGN_EPI = false, bool SP2 = false>
__device__ __forceinline__ void gemm_phase(PG8_LAS unsigned char* lds, const Gemm g, const Sched& S, const Epi& E, int tid_in) {
    int tid_l = tid_in; asm volatile("" : "+v"(tid_l)); const int tid = tid_l, wid = __builtin_amdgcn_readfirstlane(tid >> 6), lane = tid & 63, wr = wid >> 2, wc = wid & 3, fr = lane & 15, fq = lane >> 4;
    const int K = g.K, nt = K / BK;
    unsigned voffA[2], voffB[2];
#pragma unroll
    for (int i = 0; i < 2; ++i) { int R, C; stage_rc(tid * 16 + i * 8192, R, C); const int Rb = Epi::PERM ? ((R & ~31) + perm32(R & 31)) : R;
        voffA[i] = (unsigned)(R * K + C) * 2u; voffB[i] = (unsigned)(Rb * K + C) * 2u; }
    const size_t kstep = (size_t)(BK * 2);
    const size_t hstep = (size_t)HALF * K * 2;
    const size_t tstep = 2 * hstep;
    const unsigned ldsw = (unsigned)wid * 1024u;
    const int aoff = lds_byte(wr * 64 + fr, fq * 8), boff = lds_byte(wc * 32 + fr, fq * 8);
#define PG8_SA(b, h) (((b) * 2 + (h)) * HTB)
#define PG8_SB(b, h) ((4 + (b) * 2 + (h)) * HTB)
#define PG8_STAGE(bufoff, gbase, voff) do { _Pragma("unroll") for (int _i = 0; _i < 2; ++_i) \
        __builtin_amdgcn_global_load_lds((const unsigned*)((const char*)(gbase) + (voff)[_i]), (PG8_LAS unsigned*)(lds + (bufoff) + ldsw + _i * 8192), 16, 0, 0); } while (0)
#define PG8_LDA(dst, b, h) do { _Pragma("unroll") for (int m = 0; m < 4; ++m) _Pragma("unroll") for (int k = 0; k < 2; ++k) dst[m][k] = *(const PG8_LAS bf16x8*)(lds + PG8_SA(b, h) + aoff + m * 2048 + k * 1024); } while (0)
#define PG8_LDB(dst, b, h) do { _Pragma("unroll") for (int n = 0; n < 2; ++n) _Pragma("unroll") for (int k = 0; k < 2; ++k) dst[n][k] = *(const PG8_LAS bf16x8*)(lds + PG8_SB(b, h) + boff + n * 2048 + k * 1024); } while (0)
#define PG8_MMA(ai, bj, At, Bt) do { __builtin_amdgcn_s_setprio(1); _Pragma("unroll") for (int m = 0; m < 4; ++m) _Pragma("unroll") for (int n = 0; n < 2; ++n) _Pragma("unroll") for (int k = 0; k < 2; ++k) \
        acc[ai][bj][m][n] = __builtin_amdgcn_mfma_f32_16x16x32_bf16(Bt[n][k], At[m][k], acc[ai][bj][m][n], 0, 0, 0); __builtin_amdgcn_s_setprio(0); } while (0)
#define PG8_WAIT_V(n) asm volatile("s_waitcnt vmcnt(" #n ")" ::: "memory")
#define PG8_WAIT_L(n) asm volatile("s_waitcnt lgkmcnt(" #n ")" ::: "memory")
#define PG8_BAR __builtin_amdgcn_s_barrier()
#define PG8_SCHED __builtin_amdgcn_sched_barrier(0)
    Unit cur, nxt; int ui = 0;
    if (!S.next(0, cur)) return;
    f32x4 acc[2][2][4][2];
#pragma unroll
    for (int a = 0; a < 2; ++a)
#pragma unroll
        for (int b = 0; b < 2; ++b)
#pragma unroll
            for (int m = 0; m < 4; ++m)
#pragma unroll
                for (int n = 0; n < 2; ++n) acc[a][b][m][n] = (f32x4){0.f, 0.f, 0.f, 0.f};
    bf16x8 At[4][2], B0[2][2], B1[2][2];
    const char* cA = (const char*)g.A + (size_t)cur.pm * tstep; const char* cB = (const char*)g.Bt + (size_t)cur.pn * tstep;
    S.a_ready(cur);
    if constexpr (SP2) {
        PG8_STAGE(PG8_SB(0, 0), cB, voffB); PG8_STAGE(PG8_SB(0, 1), cB + hstep, voffB); PG8_STAGE(PG8_SA(0, 0), cA, voffA); PG8_STAGE(PG8_SA(0, 1), cA + hstep, voffA);
        if (wr == 1) PG8_BAR;
        PG8_WAIT_V(2); PG8_BAR;
        PG8_STAGE(PG8_SB(1, 0), cB + kstep, voffB); PG8_STAGE(PG8_SA(1, 0), cA + kstep, voffA); PG8_STAGE(PG8_SB(1, 1), cB + hstep + kstep, voffB);
        PG8_WAIT_V(6); PG8_BAR;
    } else {
        PG8_STAGE(PG8_SB(0, 0), cB, voffB); PG8_STAGE(PG8_SA(0, 0), cA, voffA); PG8_STAGE(PG8_SB(0, 1), cB + hstep, voffB); PG8_STAGE(PG8_SA(0, 1), cA + hstep, voffA);
        if (wr == 1) PG8_BAR;
        PG8_WAIT_V(4); PG8_BAR;
        PG8_STAGE(PG8_SB(1, 0), cB + kstep, voffB); PG8_STAGE(PG8_SA(1, 0), cA + kstep, voffA); PG8_STAGE(PG8_SB(1, 1), cB + hstep + kstep, voffB);
        PG8_WAIT_V(6); PG8_BAR;
    }
    for (;;) {
        const bool has_next = S.next(ui + 1, nxt);
        const char* nA = has_next ? (const char*)g.A + (size_t)nxt.pm * tstep : cA; const char* nB = has_next ? (const char*)g.Bt + (size_t)nxt.pn * tstep : cB;
        for (int t = 0; t < nt; t += 2) {
            const bool last = (t == nt - 2);
            const char* a1 = cA + (size_t)(t + 1) * kstep;
            const char* a2 = last ? nA : cA + (size_t)(t + 2) * kstep; const char* b2 = last ? nB : cB + (size_t)(t + 2) * kstep;
            const char* a3 = a2 + kstep; const char* b3 = b2 + kstep;
            if (last && has_next) S.a_ready(nxt);
            if constexpr (SP2) {
            PG8_LDB(B0, 0, 0); PG8_LDB(B1, 0, 1); PG8_SCHED; PG8_LDA(At, 0, 0); PG8_STAGE(PG8_SA(1, 1), a1 + hstep, voffA);
            PG8_WAIT_V(8); PG8_WAIT_L(0); PG8_BAR; PG8_MMA(0, 0, At, B0); PG8_MMA(0, 1, At, B1); PG8_BAR; PG8_SCHED;
            PG8_LDA(At, 0, 1); PG8_STAGE(PG8_SB(0, 0), b2, voffB); PG8_STAGE(PG8_SB(0, 1), b2 + hstep, voffB); PG8_STAGE(PG8_SA(0, 0), a2, voffA);
            PG8_WAIT_V(8); PG8_WAIT_L(0); PG8_BAR; PG8_MMA(1, 0, At, B0); PG8_MMA(1, 1, At, B1); PG8_BAR; PG8_SCHED;
            PG8_LDB(B0, 1, 0); PG8_LDB(B1, 1, 1); PG8_SCHED; PG8_LDA(At, 1, 0); PG8_STAGE(PG8_SA(0, 1), a2 + hstep, voffA);
            PG8_WAIT_V(8); PG8_WAIT_L(0); PG8_BAR; PG8_MMA(0, 0, At, B0); PG8_MMA(0, 1, At, B1); PG8_BAR; PG8_SCHED;
            PG8_LDA(At, 1, 1); PG8_STAGE(PG8_SB(1, 0), b3, voffB); PG8_STAGE(PG8_SB(1, 1), b3 + hstep, voffB); PG8_STAGE(PG8_SA(1, 0), a3, voffA);
            PG8_WAIT_V(8); PG8_WAIT_L(0); PG8_BAR; PG8_MMA(1, 0, At, B0); PG8_MMA(1, 1, At, B1); PG8_BAR; PG8_SCHED;
            } else {
            PG8_LDB(B0, 0, 0); PG8_SCHED; PG8_LDA(At, 0, 0); PG8_STAGE(PG8_SA(1, 1), a1 + hstep, voffA);
            PG8_WAIT_L(8); PG8_BAR; PG8_WAIT_L(0); PG8_MMA(0, 0, At, B0); PG8_BAR; PG8_SCHED;
            PG8_LDB(B1, 0, 1); PG8_STAGE(PG8_SB(0, 0), b2, voffB);
            PG8_BAR; PG8_WAIT_L(0); PG8_MMA(0, 1, At, B1); PG8_BAR;
            PG8_LDA(At, 0, 1); PG8_STAGE(PG8_SA(0, 0), a2, voffA);
            PG8_BAR; PG8_WAIT_L(0); PG8_MMA(1, 0, At, B0); PG8_BAR; PG8_SCHED;
            PG8_STAGE(PG8_SB(0, 1), b2 + hstep, voffB);
            PG8_WAIT_V(6); PG8_BAR; PG8_MMA(1, 1, At, B1); PG8_BAR;
            PG8_LDB(B0, 1, 0); PG8_SCHED; PG8_LDA(At, 1, 0); PG8_STAGE(PG8_SA(0, 1), a2 + hstep, voffA);
            PG8_WAIT_L(8); PG8_BAR; PG8_WAIT_L(0); PG8_MMA(0, 0, At, B0); PG8_BAR; PG8_SCHED;
            PG8_LDB(B1, 1, 1); PG8_STAGE(PG8_SB(1, 0), b3, voffB);
            PG8_BAR; PG8_WAIT_L(0); PG8_MMA(0, 1, At, B1); PG8_BAR;
            PG8_LDA(At, 1, 1); PG8_STAGE(PG8_SA(1, 0), a3, voffA);
            PG8_BAR; PG8_WAIT_L(0); PG8_MMA(1, 0, At, B0); PG8_BAR; PG8_SCHED;
            PG8_STAGE(PG8_SB(1, 1), b3 + hstep, voffB);
            PG8_WAIT_V(6); PG8_BAR; PG8_MMA(1, 1, At, B1); PG8_BAR;
            }
        }
        if constexpr (ALIGN_EPI) { if (wr == 0) PG8_BAR; }
        if constexpr (!Epi::AFTER_DRAIN) { E(acc, cur, wr, wc, fr, fq); S.done(cur); }
        if (!has_next) break;
#pragma unroll
        for (int a = 0; a < 2; ++a)
#pragma unroll
            for (int b = 0; b < 2; ++b)
#pragma unroll
                for (int m = 0; m < 4; ++m)
#pragma unroll
                    for (int n = 0; n < 2; ++n) acc[a][b][m][n] = (f32x4){0.f, 0.f, 0.f, 0.f};
        cur = nxt; cA = nA; cB = nB; ++ui;
        if constexpr (ALIGN_EPI) { if (wr == 1) PG8_BAR; }
    }
    PG8_WAIT_V(0);
    if constexpr (!ALIGN_EPI) { if (wr == 0) PG8_BAR; }
    PG8_BAR;
    if constexpr (Epi::AFTER_DRAIN) { E.fused(acc, cur, wr, wc, fr, fq, lds, wid, lane); S.done(cur); }
#undef PG8_SA
#undef PG8_SB
#undef PG8_STAGE
#undef PG8_LDA
#undef PG8_LDB
#undef PG8_MMA
#undef PG8_WAIT_V
#undef PG8_WAIT_L
#undef PG8_BAR
#undef PG8_SCHED
}
}
using pg8::bf16_t; using pg8::bf16x8; using pg8::f32x4; using pg8::u32x4; using pg8::Unit; using pg8::cvt_pk_bf16;
#define LAS __attribute__((address_space(3)))
typedef float f32x16 __attribute__((ext_vector_type(16)));
typedef short s16x4 __attribute__((ext_vector_type(4)));
typedef short v4i16_t __attribute__((ext_vector_type(4)));
typedef float f32x2_t __attribute__((ext_vector_type(2)));
typedef __bf16 bf16x2_t __attribute__((ext_vector_type(2)));
typedef unsigned u32x2 __attribute__((ext_vector_type(2)));

constexpr int S_ = 16384, DM = 1024, DFF = 2816;
constexpr float EPS = 1e-6f, LOG2E = 1.4426950408889634f;
constexpr float C2_64 = 0.125f * LOG2E;
constexpr float C2_96 = 0.10206207261596575f * LOG2E;
constexpr int LDS_BYTES = 131072 + 64, XB_LDS_OFF = 131072;

constexpr size_t MiB = 1u << 20;
constexpr size_t WS_BAR = 0;
constexpr size_t WS_CS = 1 * MiB;
constexpr size_t WS_LSE = 3 * MiB;
constexpr size_t WS_WIN = 8 * MiB;
constexpr size_t WS_WUQ = 16 * MiB;
constexpr size_t WS_WUKV = 17 * MiB;
constexpr size_t WS_EWOUT = 18 * MiB;
constexpr size_t WS_OQKV = 22 * MiB;
constexpr size_t WS_OWOUT = 27 * MiB;
constexpr size_t WS_WGU = 31 * MiB;
constexpr size_t WS_WD = 75 * MiB;
constexpr size_t WS_HB = 98 * MiB;
constexpr size_t WS_ACT = 130 * MiB;
constexpr size_t WS_CQ = WS_ACT;
constexpr size_t WS_CKV = WS_ACT + 8 * MiB;
constexpr size_t WS_QB = WS_ACT + 12 * MiB;
constexpr size_t WS_KB = WS_ACT + 28 * MiB;
constexpr size_t WS_VB = WS_ACT + 44 * MiB;
constexpr size_t WS_QA = WS_ACT + 60 * MiB;
constexpr size_t WS_KA = WS_ACT + 84 * MiB;
constexpr size_t WS_VA = WS_ACT + 108 * MiB;
constexpr size_t WS_OCAT = WS_ACT + 124 * MiB;
constexpr size_t WS_DPART = WS_ACT + 156 * MiB;
constexpr size_t WS_SSP = WS_ACT + 204 * MiB;
constexpr size_t WS_END = WS_ACT + 214 * MiB;
constexpr size_t WS_OQ = WS_ACT;
constexpr size_t WS_OK = WS_ACT + 32 * MiB;
constexpr size_t WS_OV = WS_ACT + 36 * MiB;
constexpr size_t WS_MID = WS_ACT;

struct Params {
  const float *x, *attn_norm, *ffn_norm, *final_norm, *e_w_in, *e_q_norm, *e_kv_norm, *e_w_uq, *e_w_ukv, *e_w_out, *o_w_qkv, *o_sinks, *o_w_out, *f_w_gate_up, *f_w_down;
  float* out; unsigned char* ws;
};

typedef const __attribute__((address_space(4))) Params* KPtr;
__device__ __forceinline__ u32x4 pack8(f32x4 a, f32x4 b) { u32x4 w; w.x = cvt_pk_bf16(a[0], a[1]); w.y = cvt_pk_bf16(a[2], a[3]); w.z = cvt_pk_bf16(b[0], b[1]); w.w = cvt_pk_bf16(b[2], b[3]); return w; }
__device__ __forceinline__ float sq4(f32x4 a) { return (a[0] * a[0] + a[1] * a[1]) + (a[2] * a[2] + a[3] * a[3]); }
__device__ __forceinline__ float ex2(float x) { return __builtin_amdgcn_exp2f(x); }
__device__ __forceinline__ float sum4v(f32x4 a) { return (a[0] + a[1]) + (a[2] + a[3]); }
__device__ __forceinline__ float sum16(const float* p) { const f32x4* q = (const f32x4*)p; return (sum4v(q[0]) + sum4v(q[1])) + (sum4v(q[2]) + sum4v(q[3])); }
__device__ __forceinline__ float* ssp_k(unsigned char* ws, int k) { return (float*)(ws + WS_SSP) + (size_t)k * S_ * 16; }
__device__ __forceinline__ float* ssq_i(unsigned char* ws, int i) { return (float*)(ws + WS_SSP) + (size_t)9 * S_ * 16 + (size_t)i * S_ * 4; }
__device__ __forceinline__ float* sskv_i(unsigned char* ws, int i) { return (float*)(ws + WS_SSP) + (size_t)9 * S_ * 16 + (size_t)(2 + i) * S_ * 4; }

#define EPI_HEAD static constexpr bool PERM = true, AFTER_DRAIN = false;
#define EPI_SIG __device__ __forceinline__ void operator()(const f32x4 (&acc)[2][2][4][2], const Unit& u, int wr, int wc, int fr_in, int fq_in) const
#define EPI_BEGIN int ln_e; asm volatile("v_mbcnt_lo_u32_b32 %0, -1, 0\n\tv_mbcnt_hi_u32_b32 %0, -1, %0" : "=v"(ln_e)); const int fr = ln_e & 15, fq = ln_e >> 4; (void)fr_in; (void)fq_in;
#define EPI_ROWLOOP _Pragma("unroll") for (int ai = 0; ai < 2; ++ai) _Pragma("unroll") for (int m = 0; m < 4; ++m)

struct EpiEvenIn { EPI_HEAD
  unsigned char* ws; int layer;
  EPI_SIG { EPI_BEGIN
    const int pn = u.pn; const int li = layer >> 1;
    const float* ss = ssp_k(ws, 2 * layer); const f32x2_t* cs = (const f32x2_t*)(ws + WS_CS);
    bf16_t *cq = (bf16_t*)(ws + WS_CQ), *ckv = (bf16_t*)(ws + WS_CKV), *kA = (bf16_t*)(ws + WS_KA), *qB = (bf16_t*)(ws + WS_QB), *kB = (bf16_t*)(ws + WS_KB), *vB = (bf16_t*)(ws + WS_VB);
    float *ssq = ssq_i(ws, li), *sskv = sskv_i(ws, li);
    EPI_ROWLOOP {
      asm volatile("" ::: "memory"); const int row = u.pm * 256 + ai * 128 + wr * 64 + m * 16 + fr;
      const float rstd = rsqrtf(sum16(ss + (size_t)row * 16) * (1.f / 1024.f) + EPS);
      if (pn == 0) {
        float sq = 0.f;
#pragma unroll
        for (int bj = 0; bj < 2; ++bj) { const f32x4 v0 = acc[ai][bj][m][0] * rstd, v1 = acc[ai][bj][m][1] * rstd; sq += sq4(v0) + sq4(v1);
          *(u32x4*)(cq + (size_t)row * 256 + bj * 128 + wc * 32 + 8 * fq) = pack8(v0, v1); }
        sq += __shfl_xor(sq, 16); sq += __shfl_xor(sq, 32);
        if (fq == 0) ssq[row * 4 + wc] = sq;
      } else if (pn == 1) {
        { const f32x4 v0 = acc[ai][0][m][0] * rstd, v1 = acc[ai][0][m][1] * rstd; float sq = sq4(v0) + sq4(v1);
          *(u32x4*)(ckv + (size_t)row * 128 + wc * 32 + 8 * fq) = pack8(v0, v1);
          sq += __shfl_xor(sq, 16); sq += __shfl_xor(sq, 32);
          if (fq == 0) sskv[row * 4 + wc] = sq; }
        if (wc == 0) {
          const f32x4 v0 = acc[ai][1][m][0] * rstd, v1 = acc[ai][1][m][1] * rstd;
          const f32x2_t c0 = cs[row * 16 + 4 * fq], c1 = cs[row * 16 + 4 * fq + 1], c2 = cs[row * 16 + 4 * fq + 2], c3 = cs[row * 16 + 4 * fq + 3];
          f32x4 y0, y1;
          y0[0] = v0[0] * c0.x - v0[1] * c0.y; y0[1] = v0[1] * c0.x + v0[0] * c0.y;
          y0[2] = v0[2] * c1.x - v0[3] * c1.y; y0[3] = v0[3] * c1.x + v0[2] * c1.y;
          y1[0] = v1[0] * c2.x - v1[1] * c2.y; y1[1] = v1[1] * c2.x + v1[0] * c2.y;
          y1[2] = v1[2] * c3.x - v1[3] * c3.y; y1[3] = v1[3] * c3.x + v1[2] * c3.y;
          const u32x4 w = pack8(y0, y1);
#pragma unroll
          for (int h = 0; h < 8; ++h) *(u32x4*)(kA + (size_t)row * 768 + h * 96 + 64 + 8 * fq) = w;
        }
      } else {
        bf16_t* dst = pn < 4 ? qB : (pn < 6 ? kB : vB); const float sc = pn < 4 ? rstd * C2_64 : rstd; const int cb = (pn & 1) * 256;
#pragma unroll
        for (int bj = 0; bj < 2; ++bj) *(u32x4*)(dst + (size_t)row * 512 + cb + bj * 128 + wc * 32 + 8 * fq) = pack8(acc[ai][bj][m][0] * sc, acc[ai][bj][m][1] * sc);
      }
    }
  }
};

struct EpiUq { EPI_HEAD
  unsigned char* ws; int li;
  EPI_SIG { EPI_BEGIN
    const float* ssq = ssq_i(ws, li); const f32x2_t* cs = (const f32x2_t*)(ws + WS_CS); bf16_t* qA = (bf16_t*)(ws + WS_QA);
    EPI_ROWLOOP {
      asm volatile("" ::: "memory"); const int row = u.pm * 256 + ai * 128 + wr * 64 + m * 16 + fr;
      const float sc = rsqrtf(sum4v(*(const f32x4*)(ssq + (size_t)row * 4)) * (1.f / 256.f) + EPS) * C2_96;
#pragma unroll
      for (int bj = 0; bj < 2; ++bj) {
        const int col = u.pn * 256 + bj * 128 + wc * 32 + 8 * fq; const int j = col % 96;
        f32x4 v0 = acc[ai][bj][m][0] * sc, v1 = acc[ai][bj][m][1] * sc;
        if (j >= 64) { const int i0 = (j - 64) >> 1;
          const f32x2_t c0 = cs[row * 16 + i0], c1 = cs[row * 16 + i0 + 1], c2 = cs[row * 16 + i0 + 2], c3 = cs[row * 16 + i0 + 3];
          f32x4 y0, y1;
          y0[0] = v0[0] * c0.x - v0[1] * c0.y; y0[1] = v0[1] * c0.x + v0[0] * c0.y;
          y0[2] = v0[2] * c1.x - v0[3] * c1.y; y0[3] = v0[3] * c1.x + v0[2] * c1.y;
          y1[0] = v1[0] * c2.x - v1[1] * c2.y; y1[1] = v1[1] * c2.x + v1[0] * c2.y;
          y1[2] = v1[2] * c3.x - v1[3] * c3.y; y1[3] = v1[3] * c3.x + v1[2] * c3.y;
          v0 = y0; v1 = y1; }
        *(u32x4*)(qA + (size_t)row * 768 + col) = pack8(v0, v1);
      }
    }
  }
};

struct EpiUkv { EPI_HEAD
  unsigned char* ws; int li;
  EPI_SIG { EPI_BEGIN
    const float* sskv = sskv_i(ws, li); bf16_t *kA = (bf16_t*)(ws + WS_KA), *vA = (bf16_t*)(ws + WS_VA);
    EPI_ROWLOOP {
      asm volatile("" ::: "memory"); const int row = u.pm * 256 + ai * 128 + wr * 64 + m * 16 + fr;
      const float sc = rsqrtf(sum4v(*(const f32x4*)(sskv + (size_t)row * 4)) * (1.f / 128.f) + EPS);
#pragma unroll
      for (int bj = 0; bj < 2; ++bj) {
        const int col = u.pn * 256 + bj * 128 + wc * 32 + 8 * fq; const int h = col >> 7, j = col & 127;
        bf16_t* dst = j < 64 ? kA + (size_t)row * 768 + h * 96 + j : vA + (size_t)row * 512 + h * 64 + (j - 64);
        *(u32x4*)dst = pack8(acc[ai][bj][m][0] * sc, acc[ai][bj][m][1] * sc);
      }
    }
  }
};

struct EpiResid { EPI_HEAD
  unsigned char* ws; int ssi;
  EPI_SIG { EPI_BEGIN
    bf16_t* hb = (bf16_t*)(ws + WS_HB); float* ssn = ssp_k(ws, ssi);
    EPI_ROWLOOP {
      asm volatile("" ::: "memory"); const int row = u.pm * 256 + ai * 128 + wr * 64 + m * 16 + fr;
      float sq = 0.f;
#pragma unroll
      for (int bj = 0; bj < 2; ++bj) {
        const size_t off = (size_t)row * 1024 + u.pn * 256 + bj * 128 + wc * 32 + 8 * fq;
        const u32x4 hv = *(const u32x4*)(hb + off);
        const f32x4 b0 = (f32x4){__uint_as_float(hv.x << 16), __uint_as_float(hv.x & 0xffff0000u), __uint_as_float(hv.y << 16), __uint_as_float(hv.y & 0xffff0000u)};
        const f32x4 b1 = (f32x4){__uint_as_float(hv.z << 16), __uint_as_float(hv.z & 0xffff0000u), __uint_as_float(hv.w << 16), __uint_as_float(hv.w & 0xffff0000u)};
        const f32x4 o0 = b0 + acc[ai][bj][m][0], o1 = b1 + acc[ai][bj][m][1];
        *(u32x4*)(hb + off) = pack8(o0, o1); sq += sq4(o0) + sq4(o1);
      }
      sq += __shfl_xor(sq, 16); sq += __shfl_xor(sq, 32);
      if (fq == 0) ssn[(size_t)row * 16 + u.pn * 4 + wc] = sq;
    }
  }
};

struct EpiSwiGLU { EPI_HEAD
  unsigned char* ws; int ssi;
  EPI_SIG { EPI_BEGIN
    const float* ss = ssp_k(ws, ssi); bf16_t* mid = (bf16_t*)(ws + WS_MID);
    EPI_ROWLOOP {
      asm volatile("" ::: "memory"); const int row = u.pm * 256 + ai * 128 + wr * 64 + m * 16 + fr;
      const float rstd = rsqrtf(sum16(ss + (size_t)row * 16) * (1.f / 1024.f) + EPS);
      f32x4 r[2];
#pragma unroll
      for (int n = 0; n < 2; ++n) { const f32x4 g = acc[ai][0][m][n] * rstd, up = acc[ai][1][m][n] * rstd;
#pragma unroll
        for (int e = 0; e < 4; ++e) r[n][e] = g[e] * __builtin_amdgcn_rcpf(1.f + ex2(-g[e] * LOG2E)) * up[e]; }
      *(u32x4*)(mid + (size_t)row * DFF + u.pn * 128 + wc * 32 + 8 * fq) = pack8(r[0], r[1]);
    }
  }
};

struct EpiOddQkv { EPI_HEAD
  unsigned char* ws; int ssi;
  EPI_SIG { EPI_BEGIN
    const int pn = u.pn;
    const float* ss = ssp_k(ws, ssi); bf16_t *q = (bf16_t*)(ws + WS_OQ), *k = (bf16_t*)(ws + WS_OK), *v = (bf16_t*)(ws + WS_OV);
    EPI_ROWLOOP {
      asm volatile("" ::: "memory"); const int row = u.pm * 256 + ai * 128 + wr * 64 + m * 16 + fr;
      const float rstd = rsqrtf(sum16(ss + (size_t)row * 16) * (1.f / 1024.f) + EPS);
#pragma unroll
      for (int bj = 0; bj < 2; ++bj) {
        const int ct = wc * 32 + 8 * fq;
        bf16_t* dst = pn < 4 ? q + (size_t)row * 1024 + pn * 256 + bj * 128 + ct : (bj == 0 ? k : v) + (size_t)row * 128 + ct;
        const float sc = pn < 4 ? rstd * C2_64 : rstd;
        *(u32x4*)dst = pack8(acc[ai][bj][m][0] * sc, acc[ai][bj][m][1] * sc);
      }
    }
  }
};

__device__ __forceinline__ unsigned cvtpk_s(float lo, float hi) { f32x2_t v = {lo, hi}; bf16x2_t b = __builtin_convertvector(v, bf16x2_t); return __builtin_bit_cast(unsigned, b); }
__device__ __forceinline__ s16x4 vtr(LAS const char* p) { return __builtin_bit_cast(s16x4, __builtin_amdgcn_ds_read_tr16_b64_v4i16((LAS v4i16_t*)p)); }
struct SoftState { float m, l, seen; f32x16 o0, o1, negm; };
#define ROFF(r) (((r) & 3) + 8 * ((r) >> 2))
__device__ __forceinline__ void soft_init(SoftState& st) { st.m = 0.f; st.l = 0.f; st.seen = 0.f; st.o0 = f32x16{}; st.o1 = f32x16{}; st.negm = f32x16{}; }

template <int DQK, int MODE, int PM = 0>
__device__ __forceinline__ void attn_subtile(SoftState& st, const bf16x8* qf, LAS const char* Ksub, int krs, LAS const char* Vsub, int vdh, int lane, bool do_mask, int a0, int a1, float f0) {
  const int r32 = lane & 31, hi = lane >> 5;
  f32x16 p0, p1;
  LAS const char* ka = Ksub + r32 * krs + hi * 16;
  bf16x8 kf0[DQK / 16], kf1[DQK / 16];
#pragma unroll
  for (int c = 0; c < DQK / 16; ++c) { kf0[c] = *(const LAS bf16x8*)(ka + c * 32); kf1[c] = *(const LAS bf16x8*)(ka + 32 * krs + c * 32); }
  __builtin_amdgcn_sched_barrier(0);
#pragma unroll
  for (int c = 0; c < DQK / 16; ++c) {
    p0 = __builtin_amdgcn_mfma_f32_32x32x16_bf16(kf0[c], qf[c], c == 0 ? st.negm : p0, 0, 0, 0);
    p1 = __builtin_amdgcn_mfma_f32_32x32x16_bf16(kf1[c], qf[c], c == 0 ? st.negm : p1, 0, 0, 0);
  }
  LAS const char* vb = Vsub + ((lane >> 4) & 1) * 32 + (lane & 3) * 8 + (4 * hi + ((lane & 15) >> 2)) * 64;
  s16x4 vl0[4], vh0[4], vl1[4], vh1[4];
#pragma unroll
  for (int kc = 0; kc < 4; ++kc) { vl0[kc] = vtr(vb + kc * 1024); vh0[kc] = vtr(vb + kc * 1024 + 512); vl1[kc] = vtr(vb + vdh + kc * 1024); vh1[kc] = vtr(vb + vdh + kc * 1024 + 512); }
  __builtin_amdgcn_sched_barrier(0);
  if (MODE == 1) {
    if (do_mask) {
#pragma unroll
      for (int r = 0; r < 16; ++r) { const int d0 = a0 - ROFF(r); if (d0 < 0) p0[r] = -INFINITY; if (d0 < 32) p1[r] = -INFINITY; }
    }
  } else if (MODE != 0) {
    const unsigned wmax = (MODE == 2) ? 128u : 127u; const float nf0 = -f0; const bool chk_k = a1 < 0;
#pragma unroll
    for (int r = 0; r < 16; ++r) {
      const int d0 = a0 - ROFF(r), d1 = d0 - 32;
      p0[r] = __builtin_fmaf(nf0, (float)d0, p0[r]); p1[r] = __builtin_fmaf(nf0, (float)d1, p1[r]);
    }
    if (do_mask) {
      if (chk_k) {
#pragma unroll
        for (int r = 0; r < 16; ++r) { const int d0 = a0 - ROFF(r), d1 = d0 - 32, k0i = a1 + ROFF(r), k1i = k0i + 32;
          if ((unsigned)d0 > wmax || k0i < 0) p0[r] = -INFINITY; if ((unsigned)d1 > wmax || k1i < 0) p1[r] = -INFINITY; }
      } else {
#pragma unroll
        for (int r = 0; r < 16; ++r) { const int d0 = a0 - ROFF(r), d1 = d0 - 32;
          if ((unsigned)d0 > wmax) p0[r] = -INFINITY; if ((unsigned)d1 > wmax) p1[r] = -INFINITY; }
      }
    }
  }
  float m0 = fmaxf(p0[0], p1[0]), m1 = fmaxf(p0[1], p1[1]), m2 = fmaxf(p0[2], p1[2]), m3 = fmaxf(p0[3], p1[3]);
#pragma unroll
  for (int r = 4; r < 16; r += 4) { m0 = fmaxf(m0, fmaxf(p0[r], p1[r])); m1 = fmaxf(m1, fmaxf(p0[r + 1], p1[r + 1])); m2 = fmaxf(m2, fmaxf(p0[r + 2], p1[r + 2])); m3 = fmaxf(m3, fmaxf(p0[r + 3], p1[r + 3])); }
  float mx = fmaxf(fmaxf(m0, m1), fmaxf(m2, m3));
  { auto rr = __builtin_amdgcn_permlane32_swap(__float_as_uint(mx), __float_as_uint(mx), false, false); mx = fmaxf(__uint_as_float(rr[0]), __uint_as_float(rr[1])); }
  const bool unset = st.seen == 0.f;
  float d = unset ? mx : fmaxf(mx, 0.f); d = (d == -INFINITY) ? 0.f : d;
  st.seen = (mx == -INFINITY) ? st.seen : 1.f;
  if (__builtin_amdgcn_ballot_w64(d != 0.f) != 0ull) {
    const float alpha = unset ? 1.f : ex2(-d);
    st.m += d;
#pragma unroll
    for (int r = 0; r < 16; ++r) { p0[r] -= d; p1[r] -= d; st.negm[r] = -st.m; }
    st.l *= alpha; st.o0 *= alpha; st.o1 *= alpha;
  }
  float s0 = 0.f, s1 = 0.f, s2 = 0.f, s3 = 0.f;
#pragma unroll
  for (int r = 0; r < 16; r += 4) {
    p0[r] = ex2(p0[r]); p1[r] = ex2(p1[r]); p0[r + 1] = ex2(p0[r + 1]); p1[r + 1] = ex2(p1[r + 1]); p0[r + 2] = ex2(p0[r + 2]); p1[r + 2] = ex2(p1[r + 2]); p0[r + 3] = ex2(p0[r + 3]); p1[r + 3] = ex2(p1[r + 3]);
    s0 += p0[r] + p1[r]; s1 += p0[r + 1] + p1[r + 1]; s2 += p0[r + 2] + p1[r + 2]; s3 += p0[r + 3] + p1[r + 3]; }
  st.l += (s0 + s1) + (s2 + s3);
  u32x4 pw[4];
#pragma unroll
  for (int q = 0; q < 2; ++q) {
    pw[q] = (u32x4){cvtpk_s(p0[8 * q], p0[8 * q + 1]), cvtpk_s(p0[8 * q + 2], p0[8 * q + 3]), cvtpk_s(p0[8 * q + 4], p0[8 * q + 5]), cvtpk_s(p0[8 * q + 6], p0[8 * q + 7])};
    pw[2 + q] = (u32x4){cvtpk_s(p1[8 * q], p1[8 * q + 1]), cvtpk_s(p1[8 * q + 2], p1[8 * q + 3]), cvtpk_s(p1[8 * q + 4], p1[8 * q + 5]), cvtpk_s(p1[8 * q + 6], p1[8 * q + 7])};
  }
#pragma unroll
  for (int kc = 0; kc < 4; ++kc) {
    const bf16x8 vf0 = (bf16x8){vl0[kc][0], vl0[kc][1], vl0[kc][2], vl0[kc][3], vh0[kc][0], vh0[kc][1], vh0[kc][2], vh0[kc][3]};
    const bf16x8 vf1 = (bf16x8){vl1[kc][0], vl1[kc][1], vl1[kc][2], vl1[kc][3], vh1[kc][0], vh1[kc][1], vh1[kc][2], vh1[kc][3]};
    const bf16x8 pb = __builtin_bit_cast(bf16x8, pw[kc]);
    st.o0 = __builtin_amdgcn_mfma_f32_32x32x16_bf16(vf0, pb, st.o0, 0, 0, 0);
    st.o1 = __builtin_amdgcn_mfma_f32_32x32x16_bf16(vf1, pb, st.o1, 0, 0, 0);
  }
}

__device__ __forceinline__ void attn_tile128(SoftState& st, const bf16x8* qf, LAS const char* Kt, int krs, LAS const char* Vt, int vdh, int lane) {
  const int r32 = lane & 31, hi = lane >> 5;
  f32x16 p[4];
  LAS const char* ka = Kt + r32 * krs + hi * 16;
#pragma unroll
  for (int h2 = 0; h2 < 2; ++h2) {
    bf16x8 kf0[6], kf1[6];
#pragma unroll
    for (int c = 0; c < 6; ++c) { kf0[c] = *(const LAS bf16x8*)(ka + (64 * h2) * krs + c * 32); kf1[c] = *(const LAS bf16x8*)(ka + (64 * h2 + 32) * krs + c * 32); }
    __builtin_amdgcn_sched_barrier(0);
#pragma unroll
    for (int c = 0; c < 6; ++c) {
      p[2 * h2] = __builtin_amdgcn_mfma_f32_32x32x16_bf16(kf0[c], qf[c], c == 0 ? st.negm : p[2 * h2], 0, 0, 0);
      p[2 * h2 + 1] = __builtin_amdgcn_mfma_f32_32x32x16_bf16(kf1[c], qf[c], c == 0 ? st.negm : p[2 * h2 + 1], 0, 0, 0);
    }
    __builtin_amdgcn_sched_barrier(0);
  }
  LAS const char* vb = Vt + ((lane >> 4) & 1) * 32 + (lane & 3) * 8 + (4 * hi + ((lane & 15) >> 2)) * 64;
  s16x4 vl0[4], vh0[4], vl1[4], vh1[4];
#pragma unroll
  for (int kc = 0; kc < 4; ++kc) { vl0[kc] = vtr(vb + kc * 1024); vh0[kc] = vtr(vb + kc * 1024 + 512); vl1[kc] = vtr(vb + vdh + kc * 1024); vh1[kc] = vtr(vb + vdh + kc * 1024 + 512); }
  __builtin_amdgcn_sched_barrier(0);
  float m0 = fmaxf(p[0][0], p[1][0]), m1 = fmaxf(p[0][1], p[1][1]), m2 = fmaxf(p[2][0], p[3][0]), m3 = fmaxf(p[2][1], p[3][1]);
#pragma unroll
  for (int r = 2; r < 16; r += 2) { m0 = fmaxf(m0, fmaxf(p[0][r], p[1][r])); m1 = fmaxf(m1, fmaxf(p[0][r + 1], p[1][r + 1])); m2 = fmaxf(m2, fmaxf(p[2][r], p[3][r])); m3 = fmaxf(m3, fmaxf(p[2][r + 1], p[3][r + 1])); }
  float mx = fmaxf(fmaxf(m0, m1), fmaxf(m2, m3));
  { auto rr = __builtin_amdgcn_permlane32_swap(__float_as_uint(mx), __float_as_uint(mx), false, false); mx = fmaxf(__uint_as_float(rr[0]), __uint_as_float(rr[1])); }
  const bool unset = st.seen == 0.f;
  float d = unset ? mx : fmaxf(mx, 0.f); d = (d == -INFINITY) ? 0.f : d;
  st.seen = (mx == -INFINITY) ? st.seen : 1.f;
  if (__builtin_amdgcn_ballot_w64(d != 0.f) != 0ull) {
    const float alpha = unset ? 1.f : ex2(-d);
    st.m += d;
#pragma unroll
    for (int r = 0; r < 16; ++r) { p[0][r] -= d; p[1][r] -= d; p[2][r] -= d; p[3][r] -= d; st.negm[r] = -st.m; }
    st.l *= alpha; st.o0 *= alpha; st.o1 *= alpha;
  }
  float s0 = 0.f, s1 = 0.f, s2 = 0.f, s3 = 0.f;
#pragma unroll
  for (int r = 0; r < 16; ++r) { p[0][r] = ex2(p[0][r]); p[1][r] = ex2(p[1][r]); p[2][r] = ex2(p[2][r]); p[3][r] = ex2(p[3][r]); s0 += p[0][r]; s1 += p[1][r]; s2 += p[2][r]; s3 += p[3][r]; }
  st.l += (s0 + s1) + (s2 + s3);
  u32x4 pw[8];
#pragma unroll
  for (int kb = 0; kb < 4; ++kb)
#pragma unroll
    for (int q = 0; q < 2; ++q)
      pw[2 * kb + q] = (u32x4){cvtpk_s(p[kb][8 * q], p[kb][8 * q + 1]), cvtpk_s(p[kb][8 * q + 2], p[kb][8 * q + 3]), cvtpk_s(p[kb][8 * q + 4], p[kb][8 * q + 5]), cvtpk_s(p[kb][8 * q + 6], p[kb][8 * q + 7])};
#pragma unroll
  for (int kc = 0; kc < 4; ++kc) {
    const bf16x8 vf0 = (bf16x8){vl0[kc][0], vl0[kc][1], vl0[kc][2], vl0[kc][3], vh0[kc][0], vh0[kc][1], vh0[kc][2], vh0[kc][3]};
    const bf16x8 vf1 = (bf16x8){vl1[kc][0], vl1[kc][1], vl1[kc][2], vl1[kc][3], vh1[kc][0], vh1[kc][1], vh1[kc][2], vh1[kc][3]};
    const bf16x8 pb = __builtin_bit_cast(bf16x8, pw[kc]);
    st.o0 = __builtin_amdgcn_mfma_f32_32x32x16_bf16(vf0, pb, st.o0, 0, 0, 0);
    st.o1 = __builtin_amdgcn_mfma_f32_32x32x16_bf16(vf1, pb, st.o1, 0, 0, 0);
    vl0[kc] = vtr(vb + (kc + 4) * 1024); vh0[kc] = vtr(vb + (kc + 4) * 1024 + 512); vl1[kc] = vtr(vb + vdh + (kc + 4) * 1024); vh1[kc] = vtr(vb + vdh + (kc + 4) * 1024 + 512);
  }
#pragma unroll
  for (int kc = 0; kc < 4; ++kc) {
    const bf16x8 vf0 = (bf16x8){vl0[kc][0], vl0[kc][1], vl0[kc][2], vl0[kc][3], vh0[kc][0], vh0[kc][1], vh0[kc][2], vh0[kc][3]};
    const bf16x8 vf1 = (bf16x8){vl1[kc][0], vl1[kc][1], vl1[kc][2], vl1[kc][3], vh1[kc][0], vh1[kc][1], vh1[kc][2], vh1[kc][3]};
    const bf16x8 pb = __builtin_bit_cast(bf16x8, pw[kc + 4]);
    st.o0 = __builtin_amdgcn_mfma_f32_32x32x16_bf16(vf0, pb, st.o0, 0, 0, 0);
    st.o1 = __builtin_amdgcn_mfma_f32_32x32x16_bf16(vf1, pb, st.o1, 0, 0, 0);
  }
}

__device__ __forceinline__ void attn_store(const SoftState& st, float l, bf16_t* Orow, int hi) {
  const float inv = 1.f / l;
#pragma unroll
  for (int g = 0; g < 4; ++g) {
    u32x2 w0, w1;
    w0.x = cvtpk_s(st.o0[4 * g] * inv, st.o0[4 * g + 1] * inv); w0.y = cvtpk_s(st.o0[4 * g + 2] * inv, st.o0[4 * g + 3] * inv);
    w1.x = cvtpk_s(st.o1[4 * g] * inv, st.o1[4 * g + 1] * inv); w1.y = cvtpk_s(st.o1[4 * g + 2] * inv, st.o1[4 * g + 3] * inv);
    *(u32x2*)(Orow + 8 * g + 4 * hi) = w0; *(u32x2*)(Orow + 32 + 8 * g + 4 * hi) = w1;
  }
}

constexpr int WK_RS = 144, WK_BYTES = 384 * WK_RS, WV_OFF = WK_BYTES, WV_DH = 384 * 64;
__device__ __forceinline__ void win_loadg(u32x4 (&kr)[6], u32x4 (&vr)[6], const bf16_t* Kg, int kpitch, const bf16_t* Vg, int vpitch, int r, int d, int b, int tid) {
#pragma unroll
  for (int i = 0; i < 6; ++i) { const int idx = tid + 512 * i, row = idx >> 3, ch = idx & 7; int j = 256 * b - 128 + row; j = j < 0 ? 0 : j; const size_t pos = (size_t)(r + d * j);
    kr[i] = *(const u32x4*)(Kg + pos * kpitch + ch * 8); vr[i] = *(const u32x4*)(Vg + pos * vpitch + ch * 8); }
}
__device__ __forceinline__ void win_stores(LAS unsigned char* lds, const u32x4 (&kr)[6], const u32x4 (&vr)[6], int tid) {
#pragma unroll
  for (int i = 0; i < 6; ++i) { const int idx = tid + 512 * i, row = idx >> 3, ch = idx & 7;
    *(LAS u32x4*)(lds + row * WK_RS + ch * 16) = kr[i]; *(LAS u32x4*)(lds + WV_OFF + (ch >> 2) * WV_DH + row * 64 + (ch & 3) * 16) = vr[i]; }
}
__device__ __forceinline__ void win_loadq(bf16x8 (&qf)[4], const bf16_t* Qg, int qpitch, int r, int d, int b, int wid, int lane) {
  const size_t pos = (size_t)(r + d * (256 * b + 32 * wid + (lane & 31)));
#pragma unroll
  for (int c = 0; c < 4; ++c) qf[c] = *(const bf16x8*)(Qg + pos * qpitch + 16 * c + 8 * (lane >> 5));
}
template <int MODE, bool SINK>
__device__ __forceinline__ void win_compute(LAS const unsigned char* lds, const bf16x8 (&qf)[4], bf16_t* Og, int opitch, float* lse, int lsepitch, int r, int d, int b, float slope2d, float sink2, int wid, int lane) {
  const int r32 = lane & 31, hi = lane >> 5;
  const size_t pos = (size_t)(r + d * (256 * b + 32 * wid + r32));
  LAS const char* ka = (LAS const char*)lds + (32 * wid + r32) * WK_RS + hi * 16;
  f32x16 p[5];
#pragma unroll
  for (int j = 0; j < 5; ++j) {
    bf16x8 kf[4];
#pragma unroll
    for (int c = 0; c < 4; ++c) kf[c] = *(const LAS bf16x8*)(ka + (32 * j) * WK_RS + c * 32);
    p[j] = f32x16{};
#pragma unroll
    for (int c = 0; c < 4; ++c) p[j] = __builtin_amdgcn_mfma_f32_32x32x16_bf16(kf[c], qf[c], p[j], 0, 0, 0);
    if (j & 1) __builtin_amdgcn_sched_barrier(0);
  }
  LAS const char* vb = (LAS const char*)lds + WV_OFF + (32 * wid) * 64 + ((lane >> 4) & 1) * 32 + (lane & 3) * 8 + (4 * hi + ((lane & 15) >> 2)) * 64;
  s16x4 vl0[2], vh0[2], vl1[2], vh1[2];
#pragma unroll
  for (int kc = 0; kc < 2; ++kc) { vl0[kc] = vtr(vb + kc * 1024); vh0[kc] = vtr(vb + kc * 1024 + 512); vl1[kc] = vtr(vb + WV_DH + kc * 1024); vh1[kc] = vtr(vb + WV_DH + kc * 1024 + 512); }
  const int e = r32 - 4 * hi; const float fe = (float)e, nf0 = -slope2d;
#pragma unroll
  for (int j = 0; j < 5; ++j)
#pragma unroll
    for (int rr = 0; rr < 16; ++rr) p[j][rr] = __builtin_fmaf(nf0, (float)(128 - 32 * j - ROFF(rr)) + fe, p[j][rr]);
  constexpr int lim0 = (MODE == 2) ? 0 : -1;
#pragma unroll
  for (int rr = 0; rr < 16; ++rr) { if (e - ROFF(rr) > lim0) p[0][rr] = -INFINITY; if (e - ROFF(rr) < 0) p[4][rr] = -INFINITY; }
  const int kabs0 = 256 * b + 32 * wid - 128;
  if (kabs0 < 0) {
    const int ka0 = kabs0 + 4 * hi;
#pragma unroll
    for (int j = 0; j < 5; ++j)
#pragma unroll
      for (int rr = 0; rr < 16; ++rr) { if (ka0 + 32 * j + ROFF(rr) < 0) p[j][rr] = -INFINITY; }
  }
  float m0 = fmaxf(p[0][0], p[1][0]), m1 = fmaxf(p[2][0], p[3][0]), m2 = fmaxf(p[4][0], p[0][1]), m3 = fmaxf(p[1][1], p[2][1]);
  m0 = fmaxf(m0, p[3][1]); m1 = fmaxf(m1, p[4][1]);
#pragma unroll
  for (int rr = 2; rr < 16; ++rr) { m0 = fmaxf(m0, fmaxf(p[0][rr], p[1][rr])); m1 = fmaxf(m1, fmaxf(p[2][rr], p[3][rr])); m2 = fmaxf(m2, p[4][rr]); }
  float mx = fmaxf(fmaxf(m0, m1), fmaxf(m2, m3));
  { auto sw = __builtin_amdgcn_permlane32_swap(__float_as_uint(mx), __float_as_uint(mx), false, false); mx = fmaxf(__uint_as_float(sw[0]), __uint_as_float(sw[1])); }
  float s0 = 0.f, s1 = 0.f, s2 = 0.f, s3 = 0.f, s4 = 0.f;
#pragma unroll
  for (int rr = 0; rr < 16; ++rr) {
    p[0][rr] = ex2(p[0][rr] - mx); p[1][rr] = ex2(p[1][rr] - mx); p[2][rr] = ex2(p[2][rr] - mx); p[3][rr] = ex2(p[3][rr] - mx); p[4][rr] = ex2(p[4][rr] - mx);
    s0 += p[0][rr]; s1 += p[1][rr]; s2 += p[2][rr]; s3 += p[3][rr]; s4 += p[4][rr]; }
  float l = ((s0 + s1) + (s2 + s3)) + s4;
  u32x4 pw[10];
#pragma unroll
  for (int j = 0; j < 5; ++j)
#pragma unroll
    for (int q = 0; q < 2; ++q)
      pw[2 * j + q] = (u32x4){cvtpk_s(p[j][8 * q], p[j][8 * q + 1]), cvtpk_s(p[j][8 * q + 2], p[j][8 * q + 3]), cvtpk_s(p[j][8 * q + 4], p[j][8 * q + 5]), cvtpk_s(p[j][8 * q + 6], p[j][8 * q + 7])};
  SoftState st; st.o0 = f32x16{}; st.o1 = f32x16{};
#pragma unroll
  for (int kc = 0; kc < 10; ++kc) {
    const int s = kc & 1;
    const bf16x8 vf0 = (bf16x8){vl0[s][0], vl0[s][1], vl0[s][2], vl0[s][3], vh0[s][0], vh0[s][1], vh0[s][2], vh0[s][3]};
    const bf16x8 vf1 = (bf16x8){vl1[s][0], vl1[s][1], vl1[s][2], vl1[s][3], vh1[s][0], vh1[s][1], vh1[s][2], vh1[s][3]};
    const bf16x8 pb = __builtin_bit_cast(bf16x8, pw[kc]);
    st.o0 = __builtin_amdgcn_mfma_f32_32x32x16_bf16(vf0, pb, st.o0, 0, 0, 0);
    st.o1 = __builtin_amdgcn_mfma_f32_32x32x16_bf16(vf1, pb, st.o1, 0, 0, 0);
    if (kc + 2 < 10) { vl0[s] = vtr(vb + (kc + 2) * 1024); vh0[s] = vtr(vb + (kc + 2) * 1024 + 512); vl1[s] = vtr(vb + WV_DH + (kc + 2) * 1024); vh1[s] = vtr(vb + WV_DH + (kc + 2) * 1024 + 512); }
  }
  l += __shfl_xor(l, 32);
  if (SINK) l += ex2(sink2 - mx);
  attn_store(st, l, Og + pos * opitch, hi);
  if (lse != nullptr && hi == 0) lse[pos * lsepitch] = mx + __builtin_amdgcn_logf(l);
}

constexpr int MK_RS = 208, MK_BYTES = 128 * MK_RS, MV_DH = 128 * 64, MBUF = MK_BYTES + 2 * MV_DH;
template <int PM = 0>
__device__ __forceinline__ void mla_unit(LAS unsigned char* lds, const bf16_t* qA, const bf16_t* kA, const bf16_t* vA, bf16_t* ocat, int h, int qb, int tid, int wid, int lane) {
  const int r32 = lane & 31, hi = lane >> 5;
  const int q0 = 256 * qb, NT = 2 * qb + 2;
  const bf16_t* Kg = kA + h * 96; const bf16_t* Vg = vA + h * 64;
  const size_t pos = (size_t)(q0 + 32 * wid + r32);
  bf16x8 qf[6];
#pragma unroll
  for (int c = 0; c < 6; ++c) qf[c] = *(const bf16x8*)(qA + pos * 768 + h * 96 + 16 * c + 8 * hi);
  int kgo[4], vgo[2];
#pragma unroll
  for (int i = 0; i < 4; ++i) { const int c13 = 64 * (wid + 8 * i) + lane, row = c13 / 13; int ch = c13 - row * 13; ch = ch > 11 ? 11 : ch; kgo[i] = (row * 768 + ch * 8) * 2; }
#pragma unroll
  for (int i = 0; i < 2; ++i) { const int cv = 64 * (wid + 8 * i) + lane, dh = cv >> 9, row = (cv & 511) >> 2, c4 = cv & 3; vgo[i] = (row * 512 + (dh * 4 + c4) * 8) * 2; }
#define MLA_DMA(t, bufi) do { const char* kt_ = (const char*)(Kg + (size_t)(128 * (t)) * 768); const char* vt_ = (const char*)(Vg + (size_t)(128 * (t)) * 512); \
    _Pragma("unroll") for (int i = 0; i < 3; ++i) __builtin_amdgcn_global_load_lds((const unsigned*)(kt_ + kgo[i]), (LAS unsigned*)(lds + (bufi) * MBUF + (wid + 8 * i) * 1024), 16, 0, 0); \
    if (wid < 2) __builtin_amdgcn_global_load_lds((const unsigned*)(kt_ + kgo[3]), (LAS unsigned*)(lds + (bufi) * MBUF + (wid + 24) * 1024), 16, 0, 0); \
    _Pragma("unroll") for (int i = 0; i < 2; ++i) __builtin_amdgcn_global_load_lds((const unsigned*)(vt_ + vgo[i]), (LAS unsigned*)(lds + (bufi) * MBUF + MK_BYTES + (wid + 8 * i) * 1024), 16, 0, 0); } while (0)
  SoftState st; soft_init(st);
  MLA_DMA(0, 0);
  __syncthreads();
  const int qlo = q0 + 32 * wid;
#pragma unroll 1
  for (int t = 0; t < NT; ++t) {
    const int buf = t & 1;
    if (t + 1 < NT) MLA_DMA(t + 1, buf ^ 1);
    if (t < 2 * qb) {
      attn_tile128(st, qf, (LAS const char*)lds + buf * MBUF, MK_RS, (LAS const char*)lds + buf * MBUF + MK_BYTES, MV_DH, lane);
    } else {
#pragma unroll 1
      for (int sub = 0; sub < 2; ++sub) {
        const int kbase = 128 * t + 64 * sub;
        if (kbase > qlo + 31) continue;
        const bool need_mask = (kbase + 63 > qlo);
        const int a0 = (qlo + r32) - (kbase + 4 * hi);
        attn_subtile<96, 1, PM>(st, qf, (LAS const char*)lds + buf * MBUF + 64 * sub * MK_RS, MK_RS, (LAS const char*)lds + buf * MBUF + MK_BYTES + 64 * sub * 64, MV_DH, lane, need_mask, a0, 0, 0.f);
      }
    }
    __syncthreads();
  }
#undef MLA_DMA
  const float l = st.l + __shfl_xor(st.l, 32);
  attn_store(st, l, ocat + pos * 1024 + h * 64, hi);
}

__device__ __forceinline__ unsigned f2bf(float f) { unsigned u = __builtin_bit_cast(unsigned, f); return (u + 0x7fffu + ((u >> 16) & 1u)) >> 16; }
__device__ __forceinline__ unsigned pk2(float lo, float hi) { return f2bf(lo) | (f2bf(hi) << 16); }
__device__ __forceinline__ float wave_sum(float v) {
#pragma unroll
  for (int o = 1; o < 64; o <<= 1) v += __shfl_xor(v, o);
  return v;
}
template <class F>
__device__ __forceinline__ void tr_item(const float* W, int K, int Nsrc, const float* gk, bf16_t* WT, int Ndst, LAS float* scr, int item, int lane, F srccol) {
  (void)scr;
  const int nblk = Ndst / 64, kb = item / nblk, nb = item - kb * nblk, k0 = 64 * kb, n = 64 * nb + lane;
  const int sc = srccol(n);
  const float* src = W + (size_t)k0 * Nsrc + (sc >= 0 ? sc : 0);
  bf16_t* dst = WT + (size_t)n * K + k0;
#pragma unroll 1
  for (int c0 = 0; c0 < 8; c0 += 4) {
    float v[4][8];
#pragma unroll
    for (int cc = 0; cc < 4; ++cc)
#pragma unroll
      for (int e = 0; e < 8; ++e) v[cc][e] = __builtin_nontemporal_load(src + (size_t)(8 * (c0 + cc) + e) * Nsrc);
#pragma unroll
    for (int cc = 0; cc < 4; ++cc) {
      if (gk) {
#pragma unroll
        for (int e = 0; e < 8; ++e) v[cc][e] *= gk[k0 + 8 * (c0 + cc) + e];
      }
      if (sc < 0) {
#pragma unroll
        for (int e = 0; e < 8; ++e) v[cc][e] = 0.f;
      }
      u32x4 o; o.x = pk2(v[cc][0], v[cc][1]); o.y = pk2(v[cc][2], v[cc][3]); o.z = pk2(v[cc][4], v[cc][5]); o.w = pk2(v[cc][6], v[cc][7]);
      *(u32x4*)(dst + 8 * (c0 + cc)) = o;
    }
  }
}
struct ColId { __device__ int operator()(int n) const { return n; } };
struct ColWin { __device__ int operator()(int n) const { if (n < 384) return n; if (n < 416) { const int j = n - 384; return 384 + (j >> 1) + 16 * (j & 1); } if (n < 512) return -1; return n - 96; } };
struct ColUq { __device__ int operator()(int n) const { const int h = n / 96, j = n - h * 96; if (j < 64) return n; const int t = j - 64; return h * 96 + 64 + (t >> 1) + 16 * (t & 1); } };
struct ColGu { __device__ int operator()(int n) const { const int pn = n >> 8, t = n & 255; return t < 128 ? 128 * pn + t : DFF + 128 * pn + (t - 128); } };

__device__ __forceinline__ void convert_ffn(KPtr pk, int l, int w, int nw, int lane) {
  unsigned char* ws = pk->ws;
  constexpr int I_GU = 16 * 88, I_WD = 44 * 16, N_F = I_GU + I_WD;
  for (int r = w; r < N_F; r += nw) {
    if (r < I_GU) tr_item(pk->f_w_gate_up + (size_t)l * DM * 2 * DFF, DM, 2 * DFF, pk->ffn_norm + l * DM, (bf16_t*)(ws + WS_WGU) + (size_t)l * 2 * DFF * DM, 2 * DFF, (LAS float*)nullptr, r, lane, ColGu());
    else tr_item(pk->f_w_down + (size_t)l * DFF * DM, DFF, DM, nullptr, (bf16_t*)(ws + WS_WD) + (size_t)l * DM * DFF, DM, (LAS float*)nullptr, r - I_GU, lane, ColId());
  }
}

__device__ __forceinline__ void prologue(KPtr pk, LAS unsigned char* lds, int tid, int wid, int lane) {
  unsigned char* ws = pk->ws;
  const int G = gridDim.x, gw = blockIdx.x * 8 + wid, NGW = G * 8, gt = blockIdx.x * 512 + tid, NGT = G * 512;
  LAS float* scr = (LAS float*)(lds + wid * 8448);
  constexpr int I_WIN = 16 * 32, I_UQ = 4 * 12, I_UKV = 2 * 16, I_EO = 16 * 16, I_OQ = 16 * 20, I_OO = 16 * 16, I_GU = 16 * 88, I_WD = 44 * 16;
  constexpr int N_E = I_WIN + I_UQ + I_UKV + I_EO, N_O = I_OQ + I_OO, N_F = I_GU + I_WD;
  constexpr int NITEMS = 2 * N_E + 2 * N_O + N_F;
  for (int it = gw; it < NITEMS; it += NGW) {
    int r = it;
    if (r < N_F) { const int l = 0;
      if (r < I_GU) tr_item(pk->f_w_gate_up + (size_t)l * DM * 2 * DFF, DM, 2 * DFF, pk->ffn_norm + l * DM, (bf16_t*)(ws + WS_WGU) + (size_t)l * 2 * DFF * DM, 2 * DFF, scr, r, lane, ColGu());
      else tr_item(pk->f_w_down + (size_t)l * DFF * DM, DFF, DM, nullptr, (bf16_t*)(ws + WS_WD) + (size_t)l * DM * DFF, DM, scr, r - I_GU, lane, ColId());
      continue; }
    r -= N_F;
    if (r < 2 * N_E) { const int i = r / N_E; r -= i * N_E;
      if (r < I_WIN) { tr_item(pk->e_w_in + (size_t)i * DM * 1952, DM, 1952, pk->attn_norm + (2 * i) * DM, (bf16_t*)(ws + WS_WIN) + (size_t)i * 2048 * DM, 2048, scr, r, lane, ColWin()); continue; } r -= I_WIN;
      if (r < I_UQ) { tr_item(pk->e_w_uq + (size_t)i * 256 * 768, 256, 768, pk->e_q_norm + i * 256, (bf16_t*)(ws + WS_WUQ) + (size_t)i * 768 * 256, 768, scr, r, lane, ColUq()); continue; } r -= I_UQ;
      if (r < I_UKV) { tr_item(pk->e_w_ukv + (size_t)i * 128 * 1024, 128, 1024, pk->e_kv_norm + i * 128, (bf16_t*)(ws + WS_WUKV) + (size_t)i * 1024 * 128, 1024, scr, r, lane, ColId()); continue; } r -= I_UKV;
      tr_item(pk->e_w_out + (size_t)i * DM * DM, DM, DM, nullptr, (bf16_t*)(ws + WS_EWOUT) + (size_t)i * DM * DM, DM, scr, r, lane, ColId());
      continue; }
    r -= 2 * N_E;
    { const int i = r / N_O; r -= i * N_O;
      if (r < I_OQ) tr_item(pk->o_w_qkv + (size_t)i * DM * 1280, DM, 1280, pk->attn_norm + (2 * i + 1) * DM, (bf16_t*)(ws + WS_OQKV) + (size_t)i * 1280 * DM, 1280, scr, r, lane, ColId());
      else tr_item(pk->o_w_out + (size_t)i * DM * DM, DM, DM, nullptr, (bf16_t*)(ws + WS_OWOUT) + (size_t)i * DM * DM, DM, scr, r - I_OQ, lane, ColId()); }
  }
  float* ss0 = ssp_k(ws, 0);
  bf16_t* hb = (bf16_t*)(ws + WS_HB);
  for (int m = gw; m < S_; m += 2 * NGW) {
    const int m2 = m + NGW;
    const bool has2 = m2 < S_;
    const f32x4* xr = (const f32x4*)(pk->x + (size_t)m * DM) + lane; const f32x4* xr2 = (const f32x4*)(pk->x + (size_t)(has2 ? m2 : m) * DM) + lane;
    f32x4 v[4], w[4]; float s = 0.f, s2 = 0.f;
#pragma unroll
    for (int j = 0; j < 4; ++j) { v[j] = __builtin_nontemporal_load(xr + 64 * j); w[j] = __builtin_nontemporal_load(xr2 + 64 * j); }
#pragma unroll
    for (int j = 0; j < 4; ++j) { s += sq4(v[j]); s2 += sq4(w[j]); }
    s = wave_sum(s); s2 = wave_sum(s2);
    u32x2* o8 = (u32x2*)(hb + (size_t)m * DM) + lane;
#pragma unroll
    for (int j = 0; j < 4; ++j) { u32x2 q; q.x = pk2(v[j][0], v[j][1]); q.y = pk2(v[j][2], v[j][3]); o8[64 * j] = q; }
    if (lane < 16) ss0[(size_t)m * 16 + lane] = lane == 0 ? s : 0.f;
    if (has2) {
      u32x2* o82 = (u32x2*)(hb + (size_t)m2 * DM) + lane;
#pragma unroll
      for (int j = 0; j < 4; ++j) { u32x2 q; q.x = pk2(w[j][0], w[j][1]); q.y = pk2(w[j][2], w[j][3]); o82[64 * j] = q; }
      if (lane < 16) ss0[(size_t)m2 * 16 + lane] = lane == 0 ? s2 : 0.f;
    }
  }
  f32x2_t* cs = (f32x2_t*)(ws + WS_CS);
  for (int i = gt; i < S_ * 16; i += NGT) { const int pos = i >> 4, k = i & 15;
    const float inv_freq = exp2f(-(float)k * (13.287712379549449f / 16.f));
    const float ang = (float)pos * inv_freq;
    const float n = rintf(ang * 0.15915494309189535f);
    float rr = fmaf(-n, 6.28125f, ang); rr = fmaf(-n, 0.0019353071795864769f, rr);
    cs[i] = (f32x2_t){__cosf(rr), __sinf(rr)}; }
}

__device__ __forceinline__ void dil_merge(const bf16_t* dpart, const float* lse, bf16_t* ocat, int gt, int NGT) {
  for (int idx = gt; idx < S_ * 64; idx += NGT) { const int pos = idx >> 6, c = idx & 63, h = c >> 3;
    const float l0 = lse[(size_t)pos * 8 + h], l1 = lse[((size_t)S_ + pos) * 8 + h], l2 = lse[((size_t)2 * S_ + pos) * 8 + h];
    const float mx = fmaxf(l0, fmaxf(l1, l2)); float w0 = ex2(l0 - mx), w1 = ex2(l1 - mx), w2 = ex2(l2 - mx); const float inv = 1.f / (w0 + w1 + w2); w0 *= inv; w1 *= inv; w2 *= inv;
    const u32x4 a = *(const u32x4*)(dpart + (size_t)pos * 512 + c * 8), b = *(const u32x4*)(dpart + ((size_t)S_ + pos) * 512 + c * 8), d = *(const u32x4*)(dpart + ((size_t)2 * S_ + pos) * 512 + c * 8);
    u32x4 o;
#pragma unroll
    for (int e = 0; e < 4; ++e) {
      const float alo = __uint_as_float(a[e] << 16), ahi = __uint_as_float(a[e] & 0xffff0000u), blo = __uint_as_float(b[e] << 16), bhi = __uint_as_float(b[e] & 0xffff0000u), dlo = __uint_as_float(d[e] << 16), dhi = __uint_as_float(d[e] & 0xffff0000u);
      o[e] = pk2(w0 * alo + w1 * blo + w2 * dlo, w0 * ahi + w1 * bhi + w2 * dhi); }
    *(u32x4*)(ocat + (size_t)pos * 1024 + 512 + c * 8) = o; }
}


#ifdef NO_GEMM
#define GEMMCALL(...) do{}while(0)
#else
#define GEMMCALL(...) __VA_ARGS__
#endif
#if defined(NO_GEMM) || (defined(ONLY_G) && ONLY_G != 0)
#define GEMMCALL0(...) do{}while(0)
#else
#define GEMMCALL0(...) __VA_ARGS__
#endif
#if defined(NO_GEMM) || (defined(ONLY_G) && ONLY_G != 1)
#define GEMMCALL1(...) do{}while(0)
#else
#define GEMMCALL1(...) __VA_ARGS__
#endif
#if defined(NO_GEMM) || (defined(ONLY_G) && ONLY_G != 2)
#define GEMMCALL2(...) do{}while(0)
#else
#define GEMMCALL2(...) __VA_ARGS__
#endif
#if defined(NO_GEMM) || (defined(ONLY_G) && ONLY_G != 3)
#define GEMMCALL3(...) do{}while(0)
#else
#define GEMMCALL3(...) __VA_ARGS__
#endif
#if defined(NO_GEMM) || (defined(ONLY_G) && ONLY_G != 4)
#define GEMMCALL4(...) do{}while(0)
#else
#define GEMMCALL4(...) __VA_ARGS__
#endif
#if defined(NO_GEMM) || (defined(ONLY_G) && ONLY_G != 5)
#define GEMMCALL5(...) do{}while(0)
#else
#define GEMMCALL5(...) __VA_ARGS__
#endif
#if defined(NO_GEMM) || (defined(ONLY_G) && ONLY_G != 6)
#define GEMMCALL6(...) do{}while(0)
#else
#define GEMMCALL6(...) __VA_ARGS__
#endif
#ifdef NO_WIN
#define WINCALL(...) do{}while(0)
#else
#define WINCALL(...) __VA_ARGS__
#endif
#ifdef NO_MLA
#define MLACALL(...) do{}while(0)
#else
#define MLACALL(...) __VA_ARGS__
#endif
#ifdef NO_PRO
#define PROCALL(...) do{}while(0)
#else
#define PROCALL(...) __VA_ARGS__
#endif

#define RLX_AGENT __ATOMIC_RELAXED, __HIP_MEMORY_SCOPE_AGENT
#define XB_TMO      128
#define XB_XCNT(j)  (256  + 64 * (j))
#define XB_XSUB(j)  (1280 + 64 * (j))
#define XB_XGEN(j)  (2304 + 64 * (j))
#define XB_TOP      3328
#define XB_TOPGEN   3392
#define XCD_BAR_WORDS 3456
#define XB_SPIN_CAP (1u << 18)

__device__ __forceinline__ unsigned xb_ld(unsigned* p)              { return __hip_atomic_load(p, __ATOMIC_RELAXED, __HIP_MEMORY_SCOPE_AGENT); }
__device__ __forceinline__ unsigned xb_add(unsigned* p, unsigned v) { return __hip_atomic_fetch_add(p, v, __ATOMIC_RELAXED, __HIP_MEMORY_SCOPE_AGENT); }
__device__ __forceinline__ unsigned xb_xcc_id() { return (unsigned)__builtin_amdgcn_s_getreg((3 << 11) | 20) & 0xFu; }
#define XB_SPIN(cond, bar) do { unsigned _sp = 0; while (cond) { __builtin_amdgcn_s_sleep(1); \
    if ((++_sp & 255u) == 0u) { if (xb_ld(&(bar)[XB_TMO])) break; if (_sp > XB_SPIN_CAP) { atomicAdd(&(bar)[XB_TMO], 1u); break; } } } } while (0)

struct XcdBarrier {
    unsigned* bar; unsigned x;
    volatile LAS unsigned* st;
};

__device__ __forceinline__ XcdBarrier xcd_barrier_post(unsigned* bar, volatile LAS unsigned* st) {
    XcdBarrier b; b.bar = bar; b.x = xb_xcc_id(); b.st = st;
    if (threadIdx.x == 0) (void)xb_add(&bar[XB_XCNT(b.x)], 1u);
    return b;
}
__device__ __forceinline__ void xcd_barrier_complete(unsigned* bar, unsigned x, unsigned& nloc, unsigned& nx) {
    const unsigned G = gridDim.x * gridDim.y * gridDim.z;
    unsigned sum, cnt, mine, sp = 0u;
    for (;;) {
        sum = 0u; cnt = 0u; mine = 0u;
#pragma unroll
        for (unsigned j = 0; j < 16; ++j) { const unsigned c = xb_ld(&bar[XB_XCNT(j)]); sum += c; cnt += (c > 0u) ? 1u : 0u; mine = (j == x) ? c : mine; }
        if (sum == G) break;
        __builtin_amdgcn_s_sleep(1);
        if ((++sp & 255u) == 0u) { if (xb_ld(&bar[XB_TMO])) break; if (sp > XB_SPIN_CAP) { atomicAdd(&bar[XB_TMO], 1u); break; } }
    }
    nloc = mine > 0u ? mine : 1u; nx = cnt > 0u ? cnt : 1u;
}

__device__ __forceinline__ void xcd_barrier(const XcdBarrier& b) {
    asm volatile("s_waitcnt vmcnt(0)" ::: "memory");
    __syncthreads();
    if (threadIdx.x == 0) {
        unsigned* bar = b.bar;
        __builtin_amdgcn_s_waitcnt(0);
        unsigned nloc = b.st[0], nx = b.st[1];
        if (nloc == 0u) { xcd_barrier_complete(bar, b.x, nloc, nx); b.st[0] = nloc; b.st[1] = nx; }
        const unsigned old = xb_add(&bar[XB_XSUB(b.x)], 1u);
        const unsigned gen = old / nloc;
        if (old + 1u == (gen + 1u) * nloc) {
            __builtin_amdgcn_fence(__ATOMIC_RELEASE, "agent");
            asm volatile("s_waitcnt vmcnt(0)" ::: "memory");
            const unsigned og = xb_add(&bar[XB_TOP], 1u);
            const unsigned tg = og / nx;
            if (og + 1u == (tg + 1u) * nx) xb_add(&bar[XB_TOPGEN], 1u);
            else XB_SPIN(xb_ld(&bar[XB_TOPGEN]) == tg, bar);
            __builtin_amdgcn_fence(__ATOMIC_ACQUIRE, "agent");
            xb_add(&bar[XB_XGEN(b.x)], 1u);
            asm volatile("s_waitcnt vmcnt(0)" ::: "memory");
        } else {
            XB_SPIN(xb_ld(&bar[XB_XGEN(b.x)]) == gen, bar);
            __builtin_amdgcn_fence(__ATOMIC_ACQUIRE, "agent");
            asm volatile("s_waitcnt vmcnt(0)" ::: "memory");
        }
    }
    __syncthreads();
}

#ifndef REP_MLA
#define REP_MLA 1
#endif
#ifndef REP_GU
#define REP_GU 1
#endif
#ifndef REP_WIN
#define REP_WIN 1
#endif
#ifndef REP_PRO
#define REP_PRO 1
#endif
#ifndef REP_SYNC
#define REP_SYNC 1
#endif
#define GSYNC() do { _Pragma("unroll 1") for (int rs_ = 0; rs_ < REP_SYNC; ++rs_) { KPtr pb_ = (KPtr)__builtin_amdgcn_kernarg_segment_ptr(); asm volatile("" : "+s"(pb_)); XcdBarrier xb_; xb_.bar = (unsigned*)(pb_->ws + WS_BAR); xb_.x = xb_xcc_id(); xb_.st = (volatile LAS unsigned*)(lds + XB_LDS_OFF); xcd_barrier(xb_); } } while (0)
__global__ void __launch_bounds__(512, 2) mega_fwd(Params p) {
  extern __shared__ __attribute__((aligned(16))) unsigned char lds_raw[];
  LAS unsigned char* lds = (LAS unsigned char*)lds_raw;
  cg::grid_group grid = cg::this_grid();
  int wid0 = __builtin_amdgcn_readfirstlane(threadIdx.x >> 6); asm volatile("" : "+s"(wid0));
  if (threadIdx.x < 2) ((volatile LAS unsigned*)(lds + XB_LDS_OFF))[threadIdx.x] = 0u;
  __syncthreads();
  { KPtr pb_ = (KPtr)__builtin_amdgcn_kernarg_segment_ptr(); (void)xcd_barrier_post((unsigned*)(pb_->ws + WS_BAR), (volatile LAS unsigned*)(lds + XB_LDS_OFF)); }
#define FRESH() KPtr pp = (KPtr)__builtin_amdgcn_kernarg_segment_ptr(); asm volatile("" : "+s"(pp)); unsigned char* ws = pp->ws; \
  int w0_ = wid0; asm volatile("" : "+s"(w0_)); int ln0_; asm volatile("v_mbcnt_lo_u32_b32 %0, -1, 0\n\tv_mbcnt_hi_u32_b32 %0, -1, %0" : "=v"(ln0_)); int tid_ = w0_ * 64 + ln0_; const int lane_ = tid_ & 63; const int wid_ = __builtin_amdgcn_readfirstlane(tid_ >> 6); (void)lane_; (void)wid_; \
  int bx = blockIdx.x; asm volatile("" : "+s"(bx)); int G = gridDim.x; asm volatile("" : "+s"(G)); \

#define WSB(off) ((bf16_t*)(ws + (off)))

  _Pragma("unroll 1") for (int rep = 0; rep < REP_PRO; ++rep) { FRESH(); PROCALL(prologue(pp, lds, tid_, wid_, lane_)); }
  { KPtr pz_ = (KPtr)__builtin_amdgcn_kernarg_segment_ptr(); asm volatile("" : "+s"(pz_)); if (pz_->ws == nullptr) grid.sync(); }
  GSYNC();

#pragma unroll 1
  for (int layer = 0; layer < 4; ++layer) {
    const int i = layer >> 1;
    const int G0 = gridDim.x, bx0 = blockIdx.x; (void)G0; (void)bx0;
    if ((layer & 1) == 0) {
      { FRESH();
        pg8::Gemm g{WSB(WS_HB), WSB(WS_WIN) + (size_t)i * 2048 * DM, S_, 2048, DM}; pg8::StaticOrder SO; SO.init(S_, 2048, G, bx);
        EpiEvenIn E{ws, layer};
        GEMMCALL0(pg8::gemm_phase<EpiEvenIn, pg8::StaticOrder, true, true>(lds, g, SO, E, tid_)); }
      GSYNC();
      { FRESH();
        pg8::Gemm g{WSB(WS_CQ), WSB(WS_WUQ) + (size_t)i * 768 * 256, S_, 768, 256}; pg8::StaticOrder SO; SO.init(S_, 768, G, bx);
        EpiUq E{ws, i};
        GEMMCALL1(pg8::gemm_phase<EpiUq, pg8::StaticOrder, true, true>(lds, g, SO, E, tid_)); }
      { FRESH();
        pg8::Gemm g{WSB(WS_CKV), WSB(WS_WUKV) + (size_t)i * 1024 * 128, S_, 1024, 128}; pg8::StaticOrder SO; SO.init(S_, 1024, G, bx);
        EpiUkv E{ws, i};
        GEMMCALL2(pg8::gemm_phase<EpiUkv, pg8::StaticOrder, true, true>(lds, g, SO, E, tid_)); }
#pragma unroll 1
      for (int un = bx0; un < 1536 * REP_WIN; un += G0) {
        FRESH();
        const int pat = (un % 1536) >> 9, rem = un & 511, h = rem >> 6, blk = rem & 63;
        const int d = pat == 0 ? 1 : (pat == 1 ? 4 : 16); const int bpr = 64 / d; const int r = blk / bpr, b = blk - r * bpr;
        { u32x4 kr[6], vr[6]; win_loadg(kr, vr, WSB(WS_KB) + h * 64, 512, WSB(WS_VB) + h * 64, 512, r, d, b, tid_); win_stores(lds, kr, vr, tid_); }
        bf16x8 qf[4]; win_loadq(qf, WSB(WS_QB) + h * 64, 512, r, d, b, wid_, lane_);
        __syncthreads();
        const float slope2d = exp2f(-(float)(h + 1)) * LOG2E * (float)d;
        WINCALL(win_compute<2, false>(lds, qf, WSB(WS_DPART) + (size_t)pat * S_ * 512 + h * 64, 512, (float*)(ws + WS_LSE) + (size_t)pat * S_ * 8 + h, 8, r, d, b, slope2d, 0.f, wid_, lane_));
        __syncthreads();
      }
      GSYNC();
#pragma unroll 1
      for (int v = bx0; v < 512 * REP_MLA; v += G0) {
        FRESH(); const int vv = v & 511, h = vv & 7, s = (vv >> 3) & 31, qb = vv < 256 ? 63 - s : s;
        MLACALL(mla_unit(lds, WSB(WS_QA), WSB(WS_KA), WSB(WS_VA), WSB(WS_OCAT), h, qb, tid_, wid_, lane_));
      }
      { FRESH(); dil_merge(WSB(WS_DPART), (const float*)(ws + WS_LSE), WSB(WS_OCAT), bx * 512 + tid_, G * 512); }
      GSYNC();
    } else {
      { FRESH();
        pg8::Gemm g{WSB(WS_HB), WSB(WS_OQKV) + (size_t)i * 1280 * DM, S_, 1280, DM}; pg8::StaticOrder SO; SO.init(S_, 1280, G, bx);
        EpiOddQkv E{ws, 2 * layer};
        GEMMCALL3(pg8::gemm_phase<EpiOddQkv, pg8::StaticOrder, true, true>(lds, g, SO, E, tid_)); }
      GSYNC();
#pragma unroll 1
      for (int un = bx0; un < 256 * REP_WIN; un += G0) {
        FRESH();
        const int kvh = (un & 255) >> 7, rem = un & 127, b = rem >> 1, qg = rem & 1;
        { u32x4 kr[6], vr[6]; win_loadg(kr, vr, WSB(WS_OK) + kvh * 64, 128, WSB(WS_OV) + kvh * 64, 128, 0, 1, b, tid_); win_stores(lds, kr, vr, tid_); }
        __syncthreads();
        bf16x8 qn[4]; win_loadq(qn, WSB(WS_OQ) + (kvh * 8 + qg * 4) * 64, 1024, 0, 1, b, wid_, lane_);
#pragma unroll 1
        for (int e = 0; e < 4; ++e) { const int qh = kvh * 8 + qg * 4 + e;
          bf16x8 qf[4];
#pragma unroll
          for (int q_ = 0; q_ < 4; ++q_) qf[q_] = qn[q_];
          if (e < 3) win_loadq(qn, WSB(WS_OQ) + (qh + 1) * 64, 1024, 0, 1, b, wid_, lane_);
          const float slope2d = exp2f(-0.5f * (float)(qh + 1)) * LOG2E;
          const float sink2 = pp->o_sinks[i * 16 + qh] * LOG2E;
          WINCALL(win_compute<3, true>(lds, qf, WSB(WS_OCAT) + qh * 64, 1024, nullptr, 0, 0, 1, b, slope2d, sink2, wid_, lane_)); }
        __syncthreads();
      }
      GSYNC();
    }
    { FRESH();
      const bf16_t* wt = (layer & 1) == 0 ? WSB(WS_EWOUT) + (size_t)i * DM * DM : WSB(WS_OWOUT) + (size_t)i * DM * DM;
      pg8::Gemm g{WSB(WS_OCAT), wt, S_, DM, DM}; pg8::StaticOrder SO; SO.init(S_, DM, G, bx);
      EpiResid E{ws, 2 * layer + 1};
      GEMMCALL4(pg8::gemm_phase<EpiResid, pg8::StaticOrder, true, true>(lds, g, SO, E, tid_)); }
    GSYNC();
    { FRESH();
      pg8::Gemm g{WSB(WS_HB), WSB(WS_WGU) + (size_t)layer * 2 * DFF * DM, S_, 2 * DFF, DM}; pg8::StaticOrder SO; SO.init(S_, 2 * DFF, G, bx);
      EpiSwiGLU E{ws, 2 * layer + 1};
      GEMMCALL5(pg8::gemm_phase<EpiSwiGLU, pg8::StaticOrder, true, true>(lds, g, SO, E, tid_)); }
    if (layer < 3) { FRESH();
      const int nwg = (S_ / 256) * (2 * DFF / 256), busy = nwg % G;
      if (busy == 0) convert_ffn(pp, layer + 1, bx * 8 + wid_, G * 8, lane_);
      else if (bx >= busy) convert_ffn(pp, layer + 1, (bx - busy) * 8 + wid_, (G - busy) * 8, lane_); }
#ifdef DUP_GU
    GSYNC();
    { FRESH();
      pg8::Gemm g{WSB(WS_HB), WSB(WS_WGU) + (size_t)layer * 2 * DFF * DM, S_, 2 * DFF, DM}; pg8::StaticOrder SO; SO.init(S_, 2 * DFF, G, bx);
      EpiSwiGLU E{ws, 2 * layer + 1};
      pg8::gemm_phase<EpiSwiGLU, pg8::StaticOrder, true, true>(lds, g, SO, E, tid_); }
#endif
    GSYNC();
    { FRESH();
      pg8::Gemm g{WSB(WS_MID), WSB(WS_WD) + (size_t)layer * DM * DFF, S_, DM, DFF}; pg8::StaticOrder SO; SO.init(S_, DM, G, bx);
      EpiResid E{ws, 2 * layer + 2};
      GEMMCALL6(pg8::gemm_phase<EpiResid, pg8::StaticOrder, true, true>(lds, g, SO, E, tid_)); }
    GSYNC();
  }
  { FRESH(); const float* ss8 = ssp_k(ws, 8); const int gw = bx * 8 + wid_, NGW = G * 8;
    f32x4 gv[4];
#pragma unroll
    for (int j = 0; j < 4; ++j) gv[j] = ((const f32x4*)pp->final_norm)[lane_ + 64 * j];
    const bf16_t* hbp = WSB(WS_HB);
    for (int m = gw; m < S_; m += NGW) { const float rstd = rsqrtf(sum16(ss8 + (size_t)m * 16) * (1.f / 1024.f) + EPS);
      const u32x2* hr = (const u32x2*)(hbp + (size_t)m * DM) + lane_; f32x4* o = (f32x4*)(pp->out + (size_t)m * DM) + lane_;
#pragma unroll
      for (int j = 0; j < 4; ++j) { const u32x2 w = hr[64 * j];
        const f32x4 hv = (f32x4){__uint_as_float(w.x << 16), __uint_as_float(w.x & 0xffff0000u), __uint_as_float(w.y << 16), __uint_as_float(w.y & 0xffff0000u)};
        __builtin_nontemporal_store(hv * rstd * gv[j], o + 64 * j); } } }
}

extern "C" void kernel_launch(void* const* d_in, const int* in_sizes, int n_in, void* d_out, int out_size, void* d_ws, size_t ws_size, hipStream_t stream) {
  static int grid = 0;
  if (grid == 0) {
    if (n_in != 15 || ws_size < WS_END) { fprintf(stderr, "kernel_launch: need 15 inputs and %zu bytes of workspace (got %d, %zu)\n", (size_t)WS_END, n_in, ws_size); grid = -1; return; }
    int dev = 0, cus = 0, per_cu = 0;
    hipGetDevice(&dev); hipDeviceGetAttribute(&cus, hipDeviceAttributeMultiprocessorCount, dev);
    hipFuncSetAttribute((const void*)mega_fwd, hipFuncAttributeMaxDynamicSharedMemorySize, LDS_BYTES);
    hipOccupancyMaxActiveBlocksPerMultiprocessor(&per_cu, (const void*)mega_fwd, 512, LDS_BYTES);
    if (per_cu < 1) { fprintf(stderr, "kernel_launch: occupancy query gave %d\n", per_cu); per_cu = 1; }
    (void)hipGetLastError();
    grid = cus;
  }
  if (grid < 0) return;
  if (hipMemsetAsync((char*)d_ws + WS_BAR, 0, 16384, stream) != hipSuccess) { fprintf(stderr, "memset failed\n"); return; }
  Params p{};
  const float** pp = (const float**)&p;
  for (int i = 0; i < 15; ++i) pp[i] = (const float*)d_in[i];
  p.out = (float*)d_out; p.ws = (unsigned char*)d_ws;
  void* args[] = {&p};
  hipError_t e = hipLaunchCooperativeKernel((const void*)mega_fwd, dim3(grid), dim3(512), args, LDS_BYTES, stream);
  if (e != hipSuccess) fprintf(stderr, "cooperative launch failed: %s (grid %d)\n", hipGetErrorString(e), grid);
}
```
